# Optimizing an MI355X kernel written in HIP

```python
import math
import jax
import jax.numpy as jnp
from jax import lax
import numpy as np

D_MODEL = 1024
BATCH = 4
SEQ = 8192
DEPTH = 2

GRID_W = 64
CTX_LEN = 256
N_MIXERS = 2
N_ATTN_LAYERS = (DEPTH + N_MIXERS - 1) // N_MIXERS
N_RWKV_LAYERS = DEPTH // N_MIXERS
N_MOD = 9
D_FF = 2816
NORM_EPS = 1e-6
DA_HEAD_DIM = 64
DA_HEADS = D_MODEL // (2 * DA_HEAD_DIM)
DA_SUBLN_EPS = 1e-5
ROPE_THETA = 10000.0
Q_BLOCK = 128
RW_HEAD = 64
RW_HEADS = D_MODEL // RW_HEAD
RW_DECAY_LORA = 64
RW_AAA_LORA = 64
RW_GATE_LORA = 160
RW_GN_EPS = 64e-5

kernel_name = 'hybrid_diffattn_rwkv7_macaron_dit'


def rmsnorm(x, w, eps=NORM_EPS):
    xf = x.astype(jnp.float32)
    y = xf * lax.rsqrt(jnp.mean(xf * xf, axis=-1, keepdims=True) + eps)
    return (y * w.astype(jnp.float32)).astype(x.dtype)


def modulate(x, w, shift, scale):
    return rmsnorm(x, w) * (1.0 + scale) + shift


def swiglu(x, w13, w2):
    gate, up = jnp.split(x @ w13, 2, axis=-1)
    return (jax.nn.silu(gate) * up) @ w2


def axial_rope_tables(n_tok, dtype):
    rows = n_tok // GRID_W
    row = jnp.repeat(jnp.arange(rows, dtype=jnp.int32), GRID_W).astype(jnp.float32)
    col = jnp.tile(jnp.arange(GRID_W, dtype=jnp.int32), rows).astype(jnp.float32)
    axis_dim = DA_HEAD_DIM // 2
    inv_freq = ROPE_THETA ** (-jnp.arange(0, axis_dim, 2, dtype=jnp.float32) / axis_dim)
    ang_r = row[:, None] * inv_freq
    ang_c = col[:, None] * inv_freq
    return (jnp.cos(ang_r).astype(dtype), jnp.sin(ang_r).astype(dtype),
            jnp.cos(ang_c).astype(dtype), jnp.sin(ang_c).astype(dtype))


def rope_1d(x, cos, sin):
    x1, x2 = jnp.split(x, 2, axis=-1)
    return jnp.concatenate([x1 * cos - x2 * sin, x2 * cos + x1 * sin], axis=-1)


def apply_axial_rope(x, cos_r, sin_r, cos_c, sin_c):
    xr, xc = jnp.split(x, 2, axis=-1)
    return jnp.concatenate([rope_1d(xr, cos_r, sin_r), rope_1d(xc, cos_c, sin_c)], axis=-1)


def diff_attention(u_lat, u_ctx, layer_idx, need_ctx, w_qkv, w_o, lam_vecs, subln_w):
    B, T, D = u_lat.shape
    lam_init = 0.8 - 0.6 * math.exp(-0.3 * layer_idx)
    lv = lam_vecs.astype(jnp.float32)
    lam = jnp.exp(jnp.sum(lv[0] * lv[1])) - jnp.exp(jnp.sum(lv[2] * lv[3])) + lam_init

    def project(u):
        n = u.shape[1]
        q, k, v = jnp.split(u @ w_qkv, 3, axis=-1)
        q = q.reshape(B, n, 2 * DA_HEADS, DA_HEAD_DIM).transpose(0, 2, 1, 3)
        k = k.reshape(B, n, 2 * DA_HEADS, DA_HEAD_DIM).transpose(0, 2, 1, 3)
        v = v.reshape(B, n, DA_HEADS, 2 * DA_HEAD_DIM).transpose(0, 2, 1, 3)
        return q, k, v

    def diff_weights(q, k):
        s = jnp.einsum('bhqd,bhkd->bhqk', q.astype(jnp.float32), k.astype(jnp.float32)) * (DA_HEAD_DIM ** -0.5)
        p = jax.nn.softmax(s, axis=-1).reshape(B, DA_HEADS, 2, q.shape[2], k.shape[2])
        return p[:, :, 0] - lam * p[:, :, 1]

    def finish(o):
        n = o.shape[1]
        o = rmsnorm(o, subln_w, DA_SUBLN_EPS) * (1.0 - lam_init)
        return o.reshape(B, n, D) @ w_o

    q_l, k_l, v_l = project(u_lat)
    q_c, k_c, v_c = project(u_ctx)
    cos_r, sin_r, cos_c, sin_c = axial_rope_tables(T, q_l.dtype)
    q_l = apply_axial_rope(q_l, cos_r, sin_r, cos_c, sin_c)
    k_l = apply_axial_rope(k_l, cos_r, sin_r, cos_c, sin_c)
    k_all = jnp.concatenate([k_l, k_c], axis=2)
    v_all = jnp.concatenate([v_l, v_c], axis=2)
    n_blk = T // Q_BLOCK
    q_blocks = q_l.reshape(B, 2 * DA_HEADS, n_blk, Q_BLOCK, DA_HEAD_DIM).transpose(2, 0, 1, 3, 4)

    def block(qb):
        a = diff_weights(qb, k_all)
        return jnp.einsum('bhqk,bhke->bhqe', a.astype(v_all.dtype), v_all)

    o_blocks = lax.map(block, q_blocks)
    o_lat = finish(o_blocks.transpose(1, 0, 3, 2, 4).reshape(B, T, DA_HEADS, 2 * DA_HEAD_DIM))
    o_ctx = None
    if need_ctx:
        a_c = diff_weights(q_c, k_c)
        o_c = jnp.einsum('bhqk,bhke->bhqe', a_c.astype(v_c.dtype), v_c)
        o_ctx = finish(o_c.transpose(0, 2, 1, 3))
    return o_lat, o_ctx


def token_shift_centred(x):
    zeros = jnp.zeros_like(x[:, :1])
    prev = jnp.concatenate([zeros, x[:, :-1]], axis=1)
    nxt = jnp.concatenate([x[:, 1:], zeros], axis=1)
    return 0.5 * (prev + nxt) - x


def rwkv_features(u, mix, w_rkv, w0, w1, w2, a0, a1, a2, g1, g2, k_k, k_a):
    B, n, D = u.shape
    xx = token_shift_centred(u)
    xs = u[None] + xx[None] * mix[:, None, None, :]
    rkv = jnp.einsum('pbtd,pde->pbte', xs[:3], w_rkv)
    r, k, v = rkv[0], rkv[1], rkv[2]
    w_raw = w0[:, None, None, :] + jnp.einsum('zbtr,zrd->zbtd', jnp.tanh(jnp.einsum('btd,zdr->zbtr', xs[3], w1)), w2)
    w_log = -jax.nn.softplus(-w_raw.astype(jnp.float32)) - 0.5
    decay = jnp.exp(-jnp.exp(w_log))
    a = jax.nn.sigmoid((a0[:, None, None, :] + jnp.einsum('zbtr,zrd->zbtd', jnp.einsum('btd,zdr->zbtr', xs[4], a1), a2)).astype(jnp.float32))
    g = jax.nn.sigmoid(xs[5] @ g1) @ g2
    kk = (k * k_k).astype(jnp.float32).reshape(B, n, RW_HEADS, RW_HEAD)
    kk = kk / jnp.maximum(jnp.sqrt(jnp.sum(kk * kk, axis=-1, keepdims=True)), 1e-12)
    kk = kk.reshape(B, n, D)
    k_dir = k.astype(jnp.float32)[None] * (1.0 + (a - 1.0) * k_a.astype(jnp.float32))
    b_dir = kk[None] * a
    return r.astype(jnp.float32), v.astype(jnp.float32), kk, k_dir, decay, b_dir, g


def stack_dirs(x_fwd, x_bwd):
    B, n, D = x_fwd.shape
    s = jnp.stack([x_fwd, x_bwd[:, ::-1]], axis=0).reshape(2, B, n, RW_HEADS, RW_HEAD)
    return s.transpose(2, 0, 1, 3, 4)


def scan_inputs(feats):
    r, v, kk, k_dir, decay, b_dir, g = feats
    return (stack_dirs(r, r), stack_dirs(decay[0], decay[1]), stack_dirs(k_dir[0], k_dir[1]),
            stack_dirs(v, v), stack_dirs(-kk, -kk), stack_dirs(b_dir[0], b_dir[1]))


def wkv7_scan(state0, r, w, k, v, a, b):
    def step(S, inp):
        r_t, w_t, k_t, v_t, a_t, b_t = inp
        Sa = jnp.einsum('zbhij,zbhj->zbhi', S, a_t)
        S = S * w_t[..., None, :] + Sa[..., :, None] * b_t[..., None, :] + v_t[..., :, None] * k_t[..., None, :]
        y = jnp.einsum('zbhij,zbhj->zbhi', S, r_t)
        return S, y
    return lax.scan(step, state0, (r, w, k, v, a, b))


def rwkv_finish(y, feats, r_k, ln_w, ln_b, w_o, out_dtype):
    r, v, kk, k_dir, decay, b_dir, g = feats
    n, B = y.shape[0], y.shape[2]
    yb = (y[:, 0] + y[::-1, 1]).transpose(1, 0, 2, 3)
    mu = jnp.mean(yb, axis=-1, keepdims=True)
    var = jnp.mean(jnp.square(yb - mu), axis=-1, keepdims=True)
    yn = ((yb - mu) * lax.rsqrt(var + RW_GN_EPS)).reshape(B, n, D_MODEL)
    yn = yn * ln_w.astype(jnp.float32) + ln_b.astype(jnp.float32)
    rh = r.reshape(B, n, RW_HEADS, RW_HEAD)
    vh = v.reshape(B, n, RW_HEADS, RW_HEAD)
    kh = k_dir.reshape(2, B, n, RW_HEADS, RW_HEAD)
    bonus = (jnp.sum(rh[None] * kh * r_k.astype(jnp.float32), axis=(0, 4))[..., None] * vh).reshape(B, n, D_MODEL)
    return ((yn + bonus).astype(out_dtype) * g) @ w_o


def rwkv_mixer(u_lat, u_ctx, need_ctx, mix, w_rkv, w0, w1, w2, a0, a1, a2, g1, g2, k_k, k_a, r_k, ln_w, ln_b, w_o):
    B = u_lat.shape[0]
    feats_c = rwkv_features(u_ctx, mix, w_rkv, w0, w1, w2, a0, a1, a2, g1, g2, k_k, k_a)
    feats_l = rwkv_features(u_lat, mix, w_rkv, w0, w1, w2, a0, a1, a2, g1, g2, k_k, k_a)
    state0 = jnp.zeros((2, B, RW_HEADS, RW_HEAD, RW_HEAD), jnp.float32)
    s_ctx, y_ctx = wkv7_scan(state0, *scan_inputs(feats_c))
    _, y_lat = wkv7_scan(s_ctx, *scan_inputs(feats_l))
    o_lat = rwkv_finish(y_lat, feats_l, r_k, ln_w, ln_b, w_o, u_lat.dtype)
    o_ctx = None
    if need_ctx:
        o_ctx = rwkv_finish(y_ctx, feats_c, r_k, ln_w, ln_b, w_o, u_ctx.dtype)
    return o_lat, o_ctx


def setup_inputs(seed: int = 0) -> dict:
    key = jax.random.key(seed)
    ks = iter(jax.random.split(key, 32))
    D = D_MODEL
    La = N_ATTN_LAYERS
    Lr = N_RWKV_LAYERS

    def nrm(shape, s):
        return jax.random.normal(next(ks), shape, jnp.float32) * s

    def uni(shape, lo, hi):
        return jax.random.uniform(next(ks), shape, jnp.float32, lo, hi)

    return {
        'x': nrm((BATCH, SEQ, D), 1.0),
        'c': nrm((BATCH, D), 1.0),
        'ctx': nrm((BATCH, CTX_LEN, D), 1.0),
        'c_ctx': nrm((D,), 1.0),
        'ada_w': nrm((DEPTH, D, N_MOD * D), 0.5 * D ** -0.5),
        'ada_b': nrm((DEPTH, N_MOD * D), 0.02),
        'norm_w': 1.0 + nrm((DEPTH, 3, D), 0.02),
        'ffn_w13': nrm((DEPTH, 2, D, 2 * D_FF), D ** -0.5),
        'ffn_w2': nrm((DEPTH, 2, D_FF, D), D_FF ** -0.5),
        'attn_w_qkv': nrm((La, D, 3 * D), D ** -0.5),
        'attn_w_o': nrm((La, D, D), D ** -0.5),
        'attn_lambda': nrm((La, 4, DA_HEAD_DIM), 0.1),
        'attn_subln_w': 1.0 + nrm((La, 2 * DA_HEAD_DIM), 0.02),
        'rwkv_mix': uni((Lr, 6, D), 0.0, 1.0),
        'rwkv_w_rkv': nrm((Lr, 3, D, D), D ** -0.5),
        'rwkv_w0': uni((Lr, 2, D), -6.0, 1.0),
        'rwkv_w1': nrm((Lr, 2, D, RW_DECAY_LORA), D ** -0.5),
        'rwkv_w2': nrm((Lr, 2, RW_DECAY_LORA, D), 0.1 * RW_DECAY_LORA ** -0.5),
        'rwkv_a0': nrm((Lr, 2, D), 0.1),
        'rwkv_a1': nrm((Lr, 2, D, RW_AAA_LORA), D ** -0.5),
        'rwkv_a2': nrm((Lr, 2, RW_AAA_LORA, D), 0.1 * RW_AAA_LORA ** -0.5),
        'rwkv_g1': nrm((Lr, D, RW_GATE_LORA), D ** -0.5),
        'rwkv_g2': nrm((Lr, RW_GATE_LORA, D), RW_GATE_LORA ** -0.5),
        'rwkv_k_k': 0.85 + nrm((Lr, D), 0.05),
        'rwkv_k_a': 1.0 + nrm((Lr, D), 0.05),
        'rwkv_r_k': nrm((Lr, RW_HEADS, RW_HEAD), 0.1),
        'rwkv_ln_w': 1.0 + nrm((Lr, D), 0.02),
        'rwkv_ln_b': nrm((Lr, D), 0.02),
        'rwkv_w_o': nrm((Lr, D, D), D ** -0.5),
        'final_norm_w': 1.0 + nrm((D,), 0.02),
    }


def reference(x, c, ctx, c_ctx, ada_w, ada_b, norm_w, ffn_w13, ffn_w2, attn_w_qkv, attn_w_o, attn_lambda, attn_subln_w, rwkv_mix, rwkv_w_rkv, rwkv_w0, rwkv_w1, rwkv_w2, rwkv_a0, rwkv_a1, rwkv_a2, rwkv_g1, rwkv_g2, rwkv_k_k, rwkv_k_a, rwkv_r_k, rwkv_ln_w, rwkv_ln_b, rwkv_w_o, final_norm_w):
    B, T, D = x.shape
    h = x
    hc = ctx
    s_lat = jax.nn.silu(c)
    s_ctx = jax.nn.silu(c_ctx)
    for l in range(DEPTH):
        last = l == DEPTH - 1
        m = (s_lat @ ada_w[l] + ada_b[l]).reshape(B, 1, N_MOD, D)
        mc = (s_ctx @ ada_w[l] + ada_b[l]).reshape(1, 1, N_MOD, D)
        h = h + 0.5 * m[:, :, 2] * swiglu(modulate(h, norm_w[l, 0], m[:, :, 0], m[:, :, 1]), ffn_w13[l, 0], ffn_w2[l, 0])
        hc = hc + 0.5 * mc[:, :, 2] * swiglu(modulate(hc, norm_w[l, 0], mc[:, :, 0], mc[:, :, 1]), ffn_w13[l, 0], ffn_w2[l, 0])
        u = modulate(h, norm_w[l, 1], m[:, :, 3], m[:, :, 4])
        uc = modulate(hc, norm_w[l, 1], mc[:, :, 3], mc[:, :, 4])
        j = l // N_MIXERS
        if l % N_MIXERS == 0:
            o, oc = diff_attention(u, uc, l, not last, attn_w_qkv[j], attn_w_o[j], attn_lambda[j], attn_subln_w[j])
        else:
            o, oc = rwkv_mixer(u, uc, not last, rwkv_mix[j], rwkv_w_rkv[j], rwkv_w0[j], rwkv_w1[j], rwkv_w2[j], rwkv_a0[j], rwkv_a1[j], rwkv_a2[j], rwkv_g1[j], rwkv_g2[j], rwkv_k_k[j], rwkv_k_a[j], rwkv_r_k[j], rwkv_ln_w[j], rwkv_ln_b[j], rwkv_w_o[j])
        h = h + m[:, :, 5] * o
        h = h + 0.5 * m[:, :, 8] * swiglu(modulate(h, norm_w[l, 2], m[:, :, 6], m[:, :, 7]), ffn_w13[l, 1], ffn_w2[l, 1])
        if not last:
            hc = hc + mc[:, :, 5] * oc
            hc = hc + 0.5 * mc[:, :, 8] * swiglu(modulate(hc, norm_w[l, 2], mc[:, :, 6], mc[:, :, 7]), ffn_w13[l, 1], ffn_w2[l, 1])
    return rmsnorm(h, final_norm_w)
```

```cpp
#include <hip/hip_runtime.h>
#include <hip/hip_cooperative_groups.h>
#include <hip/hip_bf16.h>
#include <cstdio>
#include <cstdint>
#include <cmath>
namespace cg = cooperative_groups;

constexpr int DM_ = 1024, NB_ = 4, T_ = 8192, CTX_ = 256, MLAT = NB_ * T_, MCTX = NB_ * CTX_, MTOK = MLAT + MCTX, FF_ = 2816, KVR = T_ + CTX_;
constexpr int NMODV = 9 * DM_;
constexpr int TID_TABLE = 131072 + 512;
__device__ __forceinline__ int hw_wave_slot() { return (int)__builtin_amdgcn_s_getreg((5 << 11) | 4); }
__device__ __forceinline__ void tid_table_init() { if ((threadIdx.x & 63) == 0) ((__attribute__((address_space(3))) int*)TID_TABLE)[hw_wave_slot()] = (int)(threadIdx.x >> 6); __syncthreads(); }
__device__ __forceinline__ int tid_opaque() { const int w = ((__attribute__((address_space(3))) int*)TID_TABLE)[hw_wave_slot()]; int t = w * 64 + (int)__builtin_amdgcn_mbcnt_hi(~0u, __builtin_amdgcn_mbcnt_lo(~0u, 0u)); asm volatile("" : "+v"(t)); return t; }
__device__ __forceinline__ int sgpr_opaque(int v) { asm volatile("" : "+s"(v)); return v; }
typedef _Float16 hf16x2_t __attribute__((ext_vector_type(2))); typedef float fl32x2_t __attribute__((ext_vector_type(2)));
__device__ __forceinline__ unsigned pkh(float a, float b) { fl32x2_t v = {a, b}; hf16x2_t x = __builtin_convertvector(v, hf16x2_t); return __builtin_bit_cast(unsigned, x); }
__device__ __forceinline__ fl32x2_t unpkh(unsigned w) { hf16x2_t x = __builtin_bit_cast(hf16x2_t, w); return __builtin_convertvector(x, fl32x2_t); }
namespace pg8 {
#define PG8_LAS __attribute__((address_space(3)))
typedef unsigned short bf16_t;
typedef short bf16x8 __attribute__((ext_vector_type(8)));
typedef float f32x4 __attribute__((ext_vector_type(4)));
typedef unsigned u32x4 __attribute__((ext_vector_type(4)));
constexpr int BM = 256, BK = 64, HALF = 128, HTB = HALF * BK * 2  , STAGE_BYTES = 8 * HTB, NXCD = 8, WGM = 8;

__host__ __device__ __forceinline__ int lds_byte(int r, int c) { const int st = (r >> 4) * 2 + (c >> 5), rr = r & 15, cc = c & 31, ob = rr * 64 + cc * 2; return st * 1024 + (ob ^ (((ob >> 9) & 1) << 5)); }
__host__ __device__ __forceinline__ void stage_rc(int b, int& R, int& C) { const int st = b / 1024, sb = b % 1024, swz = sb ^ (((sb >> 9) & 1) << 5); R = (st >> 1) * 16 + swz / 64; C = (st & 1) * 32 + (swz % 64) / 2; }
__host__ __device__ __forceinline__ int perm32(int rho) { const int n = rho >> 4, i = rho & 15; return 8 * (i >> 2) + 4 * n + (i & 3); }

struct Unit { int pm, pn, koff; };
struct Gemm { const bf16_t* A; const bf16_t* Bt; int M, N, K, lda, ldb; };

struct StaticOrder {
    int nM, nN, nwg, G, c;
    __host__ __device__ void init(int M, int N, int G_, int c_) { nM = M / BM; nN = N / BM; nwg = nM * nN; G = G_; c = c_; }
    __host__ __device__ bool next(int i, Unit& u) const {
        const long L = (long)i * G + c; if (L >= nwg) return false;
        int wgid = (int)L; { const int q = nwg / NXCD, r = nwg % NXCD, xcd = wgid % NXCD, off = wgid / NXCD; wgid = (xcd < r ? xcd * (q + 1) : r * (q + 1) + (xcd - r) * q) + off; }
        const int nig = WGM * nN, gid = wgid / nig, fm = gid * WGM, gsz = (nM - fm) < WGM ? (nM - fm) : WGM;
        u.pm = fm + ((wgid % nig) % gsz); u.pn = (wgid % nig) / gsz; u.koff = 0; return true;
    }
    __device__ __forceinline__ void a_ready(const Unit&) const {}
    __device__ __forceinline__ void done(const Unit&) const {}
};
struct CtxSplitOrder {
    int c, khalf_bytes;
    __host__ __device__ bool next(int i, Unit& u) const { if (i > 0 || c >= 32) return false; u.pm = 128 + (c >> 3); u.pn = (c >> 1) & 3; u.koff = (c & 1) * khalf_bytes; return true; }
    __device__ __forceinline__ void a_ready(const Unit&) const {}
    __device__ __forceinline__ void done(const Unit&) const {}
};

__device__ __forceinline__ unsigned cvt_pk_bf16(float lo, float hi) { unsigned r; asm volatile("v_cvt_pk_bf16_f32 %0, %1, %2" : "=v"(r) : "v"(lo), "v"(hi)); return r; }
typedef float f32x2 __attribute__((ext_vector_type(2)));
typedef unsigned u32x2 __attribute__((ext_vector_type(2)));
__device__ __forceinline__ float fast_sigmoid(float x) { return __builtin_amdgcn_rcpf(1.0f + __expf(-x)); }

struct EpiSwiglu {
    static constexpr bool PERM = true, AFTER_DRAIN = false;
    bf16_t* O; int ldc;
    __device__ __forceinline__ void operator()(const f32x4 (&acc)[2][2][4][2], const Unit& u, int wr, int wc, int fr, int fq) const {
        const int row0 = u.pm * BM + wr * 64 + fr, col0 = u.pn * HALF + wc * 32 + 8 * fq;
#pragma unroll
        for (int ai = 0; ai < 2; ++ai)
#pragma unroll
            for (int m = 0; m < 4; ++m) {
                bf16_t* rowp = O + (size_t)(row0 + ai * HALF + m * 16) * ldc + col0;
                float v[8];
#pragma unroll
                for (int n = 0; n < 2; ++n)
#pragma unroll
                    for (int j = 0; j < 4; ++j) { const float g = acc[ai][0][m][n][j], up = acc[ai][1][m][n][j]; v[n * 4 + j] = g * fast_sigmoid(g) * up; }
                u32x4 w; w.x = cvt_pk_bf16(v[0], v[1]); w.y = cvt_pk_bf16(v[2], v[3]); w.z = cvt_pk_bf16(v[4], v[5]); w.w = cvt_pk_bf16(v[6], v[7]);
                *(u32x4*)rowp = w;
            }
    }
};

struct EpiRes {
    static constexpr bool PERM = true, AFTER_DRAIN = false;
    const float* src_f32; const bf16_t* src_bf; bf16_t* dst; const float* gate;   float gs;
    __device__ __forceinline__ void operator()(const f32x4 (&acc)[2][2][4][2], const Unit& u, int wr, int wc, int fr, int fq) const {
        const int bb = u.pm >> 5; const size_t tb = (size_t)u.pm * BM * 1024; const int col0 = u.pn * BM + wc * 32 + 8 * fq;
        f32x4 gv[2][2];
#pragma unroll
        for (int bj = 0; bj < 2; ++bj)
#pragma unroll
            for (int n = 0; n < 2; ++n) gv[bj][n] = *(const f32x4*)(gate + bb * 9216 + col0 + bj * HALF + n * 4) * gs;
#pragma unroll
        for (int ai = 0; ai < 2; ++ai)
#pragma unroll
            for (int m = 0; m < 4; ++m) { const size_t off = tb + (size_t)(ai * HALF + wr * 64 + m * 16 + fr) * 1024 + col0;
#pragma unroll
                for (int bj = 0; bj < 2; ++bj) { f32x4 s0, s1;
                    if (src_f32) { s0 = *(const f32x4*)(src_f32 + off + bj * HALF); s1 = *(const f32x4*)(src_f32 + off + bj * HALF + 4); }
                    else { const u32x4 w = *(const u32x4*)(src_bf + off + bj * HALF);
                        const fl32x2_t a0 = unpkh(w.x), a1 = unpkh(w.y), a2 = unpkh(w.z), a3 = unpkh(w.w); s0 = (f32x4){a0.x, a0.y, a1.x, a1.y}; s1 = (f32x4){a2.x, a2.y, a3.x, a3.y}; }
                    const f32x4 r0 = s0 + gv[bj][0] * acc[ai][bj][m][0], r1 = s1 + gv[bj][1] * acc[ai][bj][m][1];
                    u32x4 o; o.x = pkh(r0[0], r0[1]); o.y = pkh(r0[2], r0[3]); o.z = pkh(r1[0], r1[1]); o.w = pkh(r1[2], r1[3]);
                    *(u32x4*)(dst + off + bj * HALF) = o; } }
    }
};

struct EpiQKV {
    static constexpr bool PERM = false, AFTER_DRAIN = false;
    bf16_t* Q; bf16_t* K; bf16_t* V; const float* costab; const float* sintab; float qscale;
    __device__ __forceinline__ void operator()(const f32x4 (&acc)[2][2][4][2], const Unit& u, int wr, int wc, int fr, int fq) const {
        const int which = u.pn >> 2, colt = (u.pn & 3) * BM + wc * 32 + 4 * fq;
        const bool isctx = u.pm >= 128; const int b = isctx ? (u.pm - 128) : (u.pm >> 5), t0 = isctx ? 0 : (u.pm & 31) * BM;
        const size_t tokrow0 = (size_t)u.pm * BM, kvrow0 = (size_t)b * KVR + (isctx ? T_ : t0);
        bf16_t* base = which == 0 ? Q + tokrow0 * 1024 : (which == 1 ? K : V) + kvrow0 * 1024;
        const float sc = which == 0 ? qscale : 1.0f; const bool rope = (which < 2) && !isctx;
#pragma unroll
        for (int ai = 0; ai < 2; ++ai)
#pragma unroll
            for (int m = 0; m < 4; ++m) { const int rowt = ai * HALF + wr * 64 + m * 16 + fr;
                f32x4 cs = (f32x4){1.f, 1.f, 1.f, 1.f}, sn = (f32x4){0.f, 0.f, 0.f, 0.f};
                if (rope) { const int t = t0 + rowt, pos = (wc & 1) ? (t & 63) : (t >> 6); cs = *(const f32x4*)(costab + pos * 16 + 4 * fq); sn = *(const f32x4*)(sintab + pos * 16 + 4 * fq); }
#pragma unroll
                for (int bj = 0; bj < 2; ++bj) { const f32x4 x1 = acc[ai][bj][m][0], x2 = acc[ai][bj][m][1];
                    const f32x4 o1 = (x1 * cs - x2 * sn) * sc, o2 = (x2 * cs + x1 * sn) * sc;
                    u32x2 w1, w2; w1.x = cvt_pk_bf16(o1[0], o1[1]); w1.y = cvt_pk_bf16(o1[2], o1[3]); w2.x = cvt_pk_bf16(o2[0], o2[1]); w2.y = cvt_pk_bf16(o2[2], o2[3]);
                    bf16_t* p = base + (size_t)rowt * 1024 + colt + bj * HALF; *(u32x2*)p = w1; *(u32x2*)(p + 16) = w2; } }
    }
};

struct EpiPlain {
    static constexpr bool PERM = true, AFTER_DRAIN = false;
    bf16_t* O; int ldc; int mode; size_t plane; bf16_t* L1;
    __device__ __forceinline__ void operator()(const f32x4 (&acc)[2][2][4][2], const Unit& u, int wr, int wc, int fr, int fq) const {
        bf16_t* base = O; int ld = ldc, colt = u.pn * BM, act = 0;
        if (mode == 1) { if (u.pn < 12) { base = O + (size_t)(u.pn >> 2) * plane; colt = (u.pn & 3) * BM; ld = 1024; } else { base = L1; colt = (u.pn - 12) * BM; ld = 768; act = u.pn - 11; } }
        const int row0 = u.pm * BM + wr * 64 + fr, col0 = colt + wc * 32 + 8 * fq;
#pragma unroll
        for (int ai = 0; ai < 2; ++ai)
#pragma unroll
            for (int m = 0; m < 4; ++m) { bf16_t* rowp = base + (size_t)(row0 + ai * HALF + m * 16) * ld + col0;
#pragma unroll
                for (int bj = 0; bj < 2; ++bj) { f32x4 v0 = acc[ai][bj][m][0], v1 = acc[ai][bj][m][1];
                    if (act == 1) {
#pragma unroll
                        for (int j = 0; j < 4; ++j) { v0[j] = 2.0f * fast_sigmoid(2.0f * v0[j]) - 1.0f; v1[j] = 2.0f * fast_sigmoid(2.0f * v1[j]) - 1.0f; } }
                    else if (act == 3) {
#pragma unroll
                        for (int j = 0; j < 4; ++j) { v0[j] = fast_sigmoid(v0[j]); v1[j] = fast_sigmoid(v1[j]); } }
                    u32x4 w; w.x = cvt_pk_bf16(v0[0], v0[1]); w.y = cvt_pk_bf16(v0[2], v0[3]); w.z = cvt_pk_bf16(v1[0], v1[1]); w.w = cvt_pk_bf16(v1[2], v1[3]);
                    *(u32x4*)(rowp + bj * HALF) = w; } }
    }
};
struct EpiResAtomic {
    static constexpr bool PERM = false, AFTER_DRAIN = false;
    float* dst_ctx; const float* gate; float gs;
    __device__ __forceinline__ void operator()(const f32x4 (&acc)[2][2][4][2], const Unit& u, int wr, int wc, int fr, int fq) const {
        float* dst = dst_ctx + (size_t)(u.pm - 128) * BM * 1024; const int col0 = u.pn * BM + wc * 32 + 4 * fq;
        f32x4 gv[2][2];
#pragma unroll
        for (int bj = 0; bj < 2; ++bj)
#pragma unroll
            for (int n = 0; n < 2; ++n) gv[bj][n] = *(const f32x4*)(gate + 4 * 9216 + col0 + bj * HALF + n * 16) * gs;
#pragma unroll
        for (int ai = 0; ai < 2; ++ai)
#pragma unroll
            for (int m = 0; m < 4; ++m) { const size_t off = (size_t)(ai * HALF + wr * 64 + m * 16 + fr) * 1024 + col0;
#pragma unroll
                for (int bj = 0; bj < 2; ++bj)
#pragma unroll
                    for (int n = 0; n < 2; ++n) { const f32x4 v = gv[bj][n] * acc[ai][bj][m][n]; float* p = dst + off + bj * HALF + n * 16;
                        unsafeAtomicAdd(p, v.x); unsafeAtomicAdd(p + 1, v.y); unsafeAtomicAdd(p + 2, v.z); unsafeAtomicAdd(p + 3, v.w); } }
    }
};

template <class Epi, class Sched, bool ALIGN_EPI = false, bool SP2 = false>
__device__ __forceinline__ void gemm_phase(PG8_LAS unsigned char* lds, const Gemm g, const Sched& S, const Epi& E) {
    const int tid = tid_opaque(), wid = __builtin_amdgcn_readfirstlane(tid >> 6), lane = tid & 63, wr = wid >> 2, wc = wid & 3, fr = lane & 15, fq = lane >> 4;
    const int K = g.K, nt = K / BK;
    unsigned voffA[2], voffB[2];
#pragma unroll
    for (int i = 0; i < 2; ++i) { int R, C; stage_rc(tid * 16 + i * 8192, R, C); const int Rb = Epi::PERM ? ((R & ~31) + perm32(R & 31)) : R;
        voffA[i] = (unsigned)(R * g.lda + C) * 2u; voffB[i] = (unsigned)(Rb * g.ldb + C) * 2u; }
    const size_t kstep = (size_t)(BK * 2);
    const size_t hstepA = (size_t)HALF * g.lda * 2, hstepB = (size_t)HALF * g.ldb * 2;
    const size_t tstepA = 2 * hstepA, tstepB = 2 * hstepB;
    const unsigned ldsw = (unsigned)wid * 1024u;
    const int aoff = lds_byte(wr * 64 + fr, fq * 8), boff = lds_byte(wc * 32 + fr, fq * 8);
#define PG8_SA(b, h) (((b) * 2 + (h)) * HTB)
#define PG8_SB(b, h) ((4 + (b) * 2 + (h)) * HTB)
#define PG8_STAGE(bufoff, gbase, voff) do { _Pragma("unroll") for (int _i = 0; _i < 2; ++_i) \
        __builtin_amdgcn_global_load_lds((const unsigned*)((const char*)(gbase) + (voff)[_i]), (PG8_LAS unsigned*)(lds + (bufoff) + ldsw + _i * 8192), 16, 0, 0); } while (0)
#define PG8_LDA(dst, b, h) do { _Pragma("unroll") for (int m = 0; m < 4; ++m) _Pragma("unroll") for (int k = 0; k < 2; ++k) dst[m][k] = *(const PG8_LAS bf16x8*)(lds + PG8_SA(b, h) + aoff + m * 2048 + k * 1024); } while (0)
#define PG8_LDB(dst, b, h) do { _Pragma("unroll") for (int n = 0; n < 2; ++n) _Pragma("unroll") for (int k = 0; k < 2; ++k) dst[n][k] = *(const PG8_LAS bf16x8*)(lds + PG8_SB(b, h) + boff + n * 2048 + k * 1024); } while (0)
#define PG8_MMA(ai, bj, At, Bt) do { __builtin_amdgcn_s_setprio(1); _Pragma("unroll") for (int m = 0; m < 4; ++m) _Pragma("unroll") for (int n = 0; n < 2; ++n) _Pragma("unroll") for (int k = 0; k < 2; ++k) \
        acc[ai][bj][m][n] = __builtin_amdgcn_mfma_f32_16x16x32_bf16(Bt[n][k], At[m][k], acc[ai][bj][m][n], 0, 0, 0); __builtin_amdgcn_s_setprio(0); } while (0)
#define PG8_WAIT_V(n) asm volatile("s_waitcnt vmcnt(" #n ")" ::: "memory")
#define PG8_WAIT_L(n) asm volatile("s_waitcnt lgkmcnt(" #n ")" ::: "memory")
#define PG8_BAR __builtin_amdgcn_s_barrier()
#define PG8_SCHED __builtin_amdgcn_sched_barrier(0)
    Unit cur, nxt; int ui = 0;
    if (!S.next(0, cur)) return;
    f32x4 acc[2][2][4][2];
#pragma unroll
    for (int a = 0; a < 2; ++a)
#pragma unroll
        for (int b = 0; b < 2; ++b)
#pragma unroll
            for (int m = 0; m < 4; ++m)
#pragma unroll
                for (int n = 0; n < 2; ++n) acc[a][b][m][n] = (f32x4){0.f, 0.f, 0.f, 0.f};
    bf16x8 At[4][2], B0[2][2], B1[2][2];
    const char* cA = (const char*)g.A + (size_t)cur.pm * tstepA + cur.koff; const char* cB = (const char*)g.Bt + (size_t)cur.pn * tstepB + cur.koff;
    S.a_ready(cur);
    if constexpr (SP2) {
        PG8_STAGE(PG8_SB(0, 0), cB, voffB); PG8_STAGE(PG8_SB(0, 1), cB + hstepB, voffB); PG8_STAGE(PG8_SA(0, 0), cA, voffA); PG8_STAGE(PG8_SA(0, 1), cA + hstepA, voffA);
        if (wr == 1) PG8_BAR;
        PG8_WAIT_V(2); PG8_BAR;
        PG8_STAGE(PG8_SB(1, 0), cB + kstep, voffB); PG8_STAGE(PG8_SA(1, 0), cA + kstep, voffA); PG8_STAGE(PG8_SB(1, 1), cB + hstepB + kstep, voffB);
        PG8_WAIT_V(6); PG8_BAR;
    } else {
        PG8_STAGE(PG8_SB(0, 0), cB, voffB); PG8_STAGE(PG8_SA(0, 0), cA, voffA); PG8_STAGE(PG8_SB(0, 1), cB + hstepB, voffB); PG8_STAGE(PG8_SA(0, 1), cA + hstepA, voffA);
        if (wr == 1) PG8_BAR;
        PG8_WAIT_V(4); PG8_BAR;
        PG8_STAGE(PG8_SB(1, 0), cB + kstep, voffB); PG8_STAGE(PG8_SA(1, 0), cA + kstep, voffA); PG8_STAGE(PG8_SB(1, 1), cB + hstepB + kstep, voffB);
        PG8_WAIT_V(6); PG8_BAR;
    }
    for (;;) {
        const bool has_next = S.next(ui + 1, nxt);
        const char* nA = has_next ? (const char*)g.A + (size_t)nxt.pm * tstepA + nxt.koff : cA; const char* nB = has_next ? (const char*)g.Bt + (size_t)nxt.pn * tstepB + nxt.koff : cB;
        for (int t = 0; t < nt; t += 2) {
            const bool last = (t == nt - 2);
            const char* a1 = cA + (size_t)(t + 1) * kstep;
            const char* a2 = last ? nA : cA + (size_t)(t + 2) * kstep; const char* b2 = last ? nB : cB + (size_t)(t + 2) * kstep;
            const char* a3 = a2 + kstep; const char* b3 = b2 + kstep;
            if (last && has_next) S.a_ready(nxt);
            if constexpr (SP2) {
            PG8_LDB(B0, 0, 0); PG8_LDB(B1, 0, 1); PG8_SCHED; PG8_LDA(At, 0, 0); PG8_STAGE(PG8_SA(1, 1), a1 + hstepA, voffA);
            PG8_WAIT_V(8); PG8_WAIT_L(0); PG8_BAR; PG8_MMA(0, 0, At, B0); PG8_MMA(0, 1, At, B1); PG8_BAR; PG8_SCHED;
            PG8_LDA(At, 0, 1); PG8_STAGE(PG8_SB(0, 0), b2, voffB); PG8_STAGE(PG8_SB(0, 1), b2 + hstepB, voffB); PG8_STAGE(PG8_SA(0, 0), a2, voffA);
            PG8_WAIT_V(8); PG8_WAIT_L(0); PG8_BAR; PG8_MMA(1, 0, At, B0); PG8_MMA(1, 1, At, B1); PG8_BAR; PG8_SCHED;
            PG8_LDB(B0, 1, 0); PG8_LDB(B1, 1, 1); PG8_SCHED; PG8_LDA(At, 1, 0); PG8_STAGE(PG8_SA(0, 1), a2 + hstepA, voffA);
            PG8_WAIT_V(8); PG8_WAIT_L(0); PG8_BAR; PG8_MMA(0, 0, At, B0); PG8_MMA(0, 1, At, B1); PG8_BAR; PG8_SCHED;
            PG8_LDA(At, 1, 1); PG8_STAGE(PG8_SB(1, 0), b3, voffB); PG8_STAGE(PG8_SB(1, 1), b3 + hstepB, voffB); PG8_STAGE(PG8_SA(1, 0), a3, voffA);
            PG8_WAIT_V(8); PG8_WAIT_L(0); PG8_BAR; PG8_MMA(1, 0, At, B0); PG8_MMA(1, 1, At, B1); PG8_BAR; PG8_SCHED;
            } else {
            PG8_LDB(B0, 0, 0); PG8_SCHED; PG8_LDA(At, 0, 0); PG8_STAGE(PG8_SA(1, 1), a1 + hstepA, voffA);
            PG8_WAIT_L(8); PG8_BAR; PG8_WAIT_L(0); PG8_MMA(0, 0, At, B0); PG8_BAR; PG8_SCHED;
            PG8_LDB(B1, 0, 1); PG8_STAGE(PG8_SB(0, 0), b2, voffB);
            PG8_BAR; PG8_WAIT_L(0); PG8_MMA(0, 1, At, B1); PG8_BAR;
            PG8_LDA(At, 0, 1); PG8_STAGE(PG8_SA(0, 0), a2, voffA);
            PG8_BAR; PG8_WAIT_L(0); PG8_MMA(1, 0, At, B0); PG8_BAR; PG8_SCHED;
            PG8_STAGE(PG8_SB(0, 1), b2 + hstepB, voffB);
            PG8_WAIT_V(6); PG8_BAR; PG8_MMA(1, 1, At, B1); PG8_BAR;
            PG8_LDB(B0, 1, 0); PG8_SCHED; PG8_LDA(At, 1, 0); PG8_STAGE(PG8_SA(0, 1), a2 + hstepA, voffA);
            PG8_WAIT_L(8); PG8_BAR; PG8_WAIT_L(0); PG8_MMA(0, 0, At, B0); PG8_BAR; PG8_SCHED;
            PG8_LDB(B1, 1, 1); PG8_STAGE(PG8_SB(1, 0), b3, voffB);
            PG8_BAR; PG8_WAIT_L(0); PG8_MMA(0, 1, At, B1); PG8_BAR;
            PG8_LDA(At, 1, 1); PG8_STAGE(PG8_SA(1, 0), a3, voffA);
            PG8_BAR; PG8_WAIT_L(0); PG8_MMA(1, 0, At, B0); PG8_BAR; PG8_SCHED;
            PG8_STAGE(PG8_SB(1, 1), b3 + hstepB, voffB);
            PG8_WAIT_V(6); PG8_BAR; PG8_MMA(1, 1, At, B1); PG8_BAR;
            }
        }
        if constexpr (ALIGN_EPI) { if (wr == 0) PG8_BAR; }
        if constexpr (!Epi::AFTER_DRAIN) { E(acc, cur, wr, wc, fr, fq); S.done(cur); }
        if (!has_next) break;
#pragma unroll
        for (int a = 0; a < 2; ++a)
#pragma unroll
            for (int b = 0; b < 2; ++b)
#pragma unroll
                for (int m = 0; m < 4; ++m)
#pragma unroll
                    for (int n = 0; n < 2; ++n) acc[a][b][m][n] = (f32x4){0.f, 0.f, 0.f, 0.f};
        cur = nxt; cA = nA; cB = nB; ++ui;
        if constexpr (ALIGN_EPI) { if (wr == 1) PG8_BAR; }
    }
    PG8_WAIT_V(0);
    if constexpr (!ALIGN_EPI) { if (wr == 0) PG8_BAR; }
    PG8_BAR;
    if constexpr (Epi::AFTER_DRAIN) { E.fused(acc, cur, wr, wc, fr, fq, lds, wid, lane); S.done(cur); }
#undef PG8_SA
#undef PG8_SB
#undef PG8_STAGE
#undef PG8_LDA
#undef PG8_LDB
#undef PG8_MMA
#undef PG8_WAIT_V
#undef PG8_WAIT_L
#undef PG8_BAR
#undef PG8_SCHED
}
}
namespace attn2 {
using bf16 = unsigned short;
using bf16x8 = __attribute__((ext_vector_type(8))) short;
using s16x4  = __attribute__((ext_vector_type(4))) short;
using f32x16 = __attribute__((ext_vector_type(16))) float;
using u32x4  = __attribute__((ext_vector_type(4))) unsigned;
constexpr int NW = 8, QBLK = 32, KVBLK = 64, LD = 1024, LDO = 2048;
constexpr float SCALE = 0.125f, THR = 8.f;
constexpr size_t SHM_V = KVBLK * 128 * 2, SHM_K = KVBLK * 64 * 2, SHM_ATTN = 2 * SHM_V + 2 * SHM_K + NW * 64 * 4;
#define KSWZ(row, colB) ((row) * 128 + ((colB) ^ (((row) & 7) << 4)))
#define SBAR() __builtin_amdgcn_sched_barrier(0)
__device__ __forceinline__ int crow(int r, int hi) { return (r & 3) + 8 * (r >> 2) + 4 * hi; }
__device__ __forceinline__ unsigned cvtpk(float lo, float hi) { unsigned r; asm volatile("v_cvt_pk_bf16_f32 %0, %1, %2" : "=v"(r) : "v"(lo), "v"(hi)); return r; }
constexpr float THRL = THR * 1.4426950408889634f;
__device__ __forceinline__ void partialSM(f32x16& p0, f32x16& p1, float& mhat, float& alpha, bool first) {
#define MX8(P, B) fmaxf(fmaxf(fmaxf(fmaxf(fmaxf(P[B], P[B + 1]), P[B + 2]), fmaxf(fmaxf(P[B + 3], P[B + 4]), P[B + 5])), P[B + 6]), P[B + 7])
  float pmax = fmaxf(fmaxf(MX8(p0, 0), MX8(p0, 8)), fmaxf(MX8(p1, 0), MX8(p1, 8)));
#undef MX8
  { auto rr = __builtin_amdgcn_permlane32_swap(__float_as_uint(pmax), __float_as_uint(pmax), false, false);
    pmax = fmaxf(__uint_as_float(rr[0]), __uint_as_float(rr[1])); }
  if (__builtin_expect(!first && __all(pmax <= THRL), 1)) { alpha = 1.f; }
  else { const float dl = first ? pmax : fmaxf(pmax, 0.f); mhat += dl; alpha = first ? 1.f : __builtin_amdgcn_exp2f(-dl);
    for (int r = 0; r < 16; ++r) { p0[r] -= dl; p1[r] -= dl; } }
  for (int r = 0; r < 16; ++r) p0[r] = __builtin_amdgcn_exp2f(p0[r]);
}
__device__ __forceinline__ void finishSM(f32x16& p0, f32x16& p1, float alpha, float& l_reg, bf16x8& pa0, bf16x8& pa1, bf16x8& pa2, bf16x8& pa3) {
  for (int r = 0; r < 16; ++r) p1[r] = __builtin_amdgcn_exp2f(p1[r]);
#define SM8(P, B) (((P[B] + P[B + 1]) + (P[B + 2] + P[B + 3])) + ((P[B + 4] + P[B + 5]) + (P[B + 6] + P[B + 7])))
  float ps = (SM8(p0, 0) + SM8(p0, 8)) + (SM8(p1, 0) + SM8(p1, 8));
#undef SM8
  { auto rr = __builtin_amdgcn_permlane32_swap(__float_as_uint(ps), __float_as_uint(ps), false, false);
    ps = __uint_as_float(rr[0]) + __uint_as_float(rr[1]); }
  l_reg = l_reg * alpha + ps;
#define PK4(P, BASE, OUT) do { unsigned a0 = cvtpk(P[BASE + 0], P[BASE + 1]), a1 = cvtpk(P[BASE + 2], P[BASE + 3]);   \
    unsigned b0 = cvtpk(P[BASE + 4], P[BASE + 5]), b1 = cvtpk(P[BASE + 6], P[BASE + 7]);                              \
    auto r0 = __builtin_amdgcn_permlane32_swap(a0, b0, false, false); auto r1 = __builtin_amdgcn_permlane32_swap(a1, b1, false, false); \
    u32x4 w = {r0[0], r1[0], r0[1], r1[1]}; OUT = *reinterpret_cast<bf16x8*>(&w); } while (0)
  PK4(p0, 0, pa0); PK4(p0, 8, pa1); PK4(p1, 0, pa2); PK4(p1, 8, pa3);
#undef PK4
}
__device__ __forceinline__ void qkt(f32x16& p0, f32x16& p1, const bf16* Ks, const bf16x8* qr, const float mhat, int r32, int hi) {
  f32x16 negm; for (int r = 0; r < 16; ++r) negm[r] = -mhat;
#pragma unroll
  for (int d0 = 0; d0 < 4; ++d0) { int cb = (d0 * 16 + hi * 8) * 2;
    bf16x8 b0 = *reinterpret_cast<const bf16x8*>((const char*)Ks + KSWZ(r32, cb));
    bf16x8 b1 = *reinterpret_cast<const bf16x8*>((const char*)Ks + KSWZ(32 + r32, cb));
    if (d0 == 0) { p0 = __builtin_amdgcn_mfma_f32_32x32x16_bf16(b0, qr[0], negm, 0, 0, 0); p1 = __builtin_amdgcn_mfma_f32_32x32x16_bf16(b1, qr[0], negm, 0, 0, 0); }
    else { p0 = __builtin_amdgcn_mfma_f32_32x32x16_bf16(b0, qr[d0], p0, 0, 0, 0); p1 = __builtin_amdgcn_mfma_f32_32x32x16_bf16(b1, qr[d0], p1, 0, 0, 0); } }
}
__device__ __forceinline__ int v_st(int k, int c) { const int kk = (k & ~0xC) | ((k & 4) << 1) | ((k & 8) >> 1); return ((kk >> 3) * 4 + (c >> 5)) * 512 + ((kk & 7) * 32 + (c & 31)) * 2; }
__device__ __forceinline__ int v_rd_base(int lane) { return ((lane & 3) << 3) | (((lane >> 2) & 3) << 6) | (((lane >> 4) & 1) << 5) | (((lane >> 5) & 1) << 8); }
constexpr int v_rd_off(int d0, int ks, int half) { return d0 * 512 + ks * 4096 + half * 2048; }
template <int OFF> __device__ __forceinline__ s16x4 tr_read(int vb) { s16x4 r; asm volatile("ds_read_b64_tr_b16 %0, %1 offset:%2" : "=&v"(r) : "v"(vb), "i"(OFF) : "memory"); return r; }
template <int D0> __device__ __forceinline__ void pv_one(f32x16& od, int vb, bf16x8 pa0, bf16x8 pa1, bf16x8 pa2, bf16x8 pa3) {
  const s16x4 l0 = tr_read<v_rd_off(D0, 0, 0)>(vb), h0 = tr_read<v_rd_off(D0, 0, 1)>(vb), l1 = tr_read<v_rd_off(D0, 1, 0)>(vb), h1 = tr_read<v_rd_off(D0, 1, 1)>(vb);
  const s16x4 l2 = tr_read<v_rd_off(D0, 2, 0)>(vb), h2 = tr_read<v_rd_off(D0, 2, 1)>(vb), l3 = tr_read<v_rd_off(D0, 3, 0)>(vb), h3 = tr_read<v_rd_off(D0, 3, 1)>(vb);
  asm volatile("s_waitcnt lgkmcnt(0)" ::: "memory"); SBAR();
#define PK(L, H) (bf16x8){L[0], L[1], L[2], L[3], H[0], H[1], H[2], H[3]}
  od = __builtin_amdgcn_mfma_f32_32x32x16_bf16(pa0, PK(l0, h0), od, 0, 0, 0);
  od = __builtin_amdgcn_mfma_f32_32x32x16_bf16(pa1, PK(l1, h1), od, 0, 0, 0);
  od = __builtin_amdgcn_mfma_f32_32x32x16_bf16(pa2, PK(l2, h2), od, 0, 0, 0);
  od = __builtin_amdgcn_mfma_f32_32x32x16_bf16(pa3, PK(l3, h3), od, 0, 0, 0);
#undef PK
}
__device__ __forceinline__ void pv_d0(f32x16* o, int vb, bf16x8 pa0, bf16x8 pa1, bf16x8 pa2, bf16x8 pa3) {
  pv_one<0>(o[0], vb, pa0, pa1, pa2, pa3); pv_one<1>(o[1], vb, pa0, pa1, pa2, pa3); pv_one<2>(o[2], vb, pa0, pa1, pa2, pa3); pv_one<3>(o[3], vb, pa0, pa1, pa2, pa3);
}
__device__ __forceinline__ void attn_dense_body(const bf16* __restrict__ Qb, const bf16* __restrict__ Kh, const bf16* __restrict__ Vh, bf16* __restrict__ Ob, int seq, char* lds) {
  const int tid = tid_opaque(), wid = tid >> 6, lane = tid & 63, r32 = lane & 31, hi = lane >> 5;
  bf16* V_lds = (bf16*)lds; bf16* K_lds = (bf16*)(lds + 2 * SHM_V);
  float* ws = (float*)(lds + 2 * SHM_V + 2 * SHM_K) + wid * 64; float* li_l = ws; float* al_l = ws + 32;
  float m_reg = 0.f, l_reg = 0; f32x16 o[4] = {}; bf16x8 qr[4];
  const bf16* Qw = Qb + (long)(wid * QBLK + r32) * LD + hi * 8;
#pragma unroll
  for (int d0 = 0; d0 < 4; ++d0) qr[d0] = *reinterpret_cast<const bf16x8*>(Qw + d0 * 16);
  const int sr = tid >> 4, sc = (tid & 15) * 8, vst0 = v_st(sr, sc), vst1 = v_st(32 + sr, sc);
  const int kr = tid >> 3, kc = (tid & 7) * 8, kst = KSWZ(kr, kc * 2);
  const int vb0 = (int)(uintptr_t)V_lds + v_rd_base(lane);
  struct { bf16x8 vs0, vs1, ks0; } sr_[2];
#define SLOAD(i, k0) do { sr_[i].vs0 = *reinterpret_cast<const bf16x8*>(&Vh[(long)((k0) + sr) * LD + sc]); sr_[i].vs1 = *reinterpret_cast<const bf16x8*>(&Vh[(long)((k0) + 32 + sr) * LD + sc]); \
    sr_[i].ks0 = *reinterpret_cast<const bf16x8*>(&Kh[(long)((k0) + kr) * LD + kc]); } while (0)
#define SWRITE(b, i) do { *(bf16x8*)((char*)V_lds + (b) * SHM_V + vst0) = sr_[i].vs0; *(bf16x8*)((char*)V_lds + (b) * SHM_V + vst1) = sr_[i].vs1; \
    *(bf16x8*)((char*)K_lds + (b) * SHM_K + kst) = sr_[i].ks0; } while (0)
#define SWAIT() asm volatile("s_waitcnt vmcnt(3)" ::: "memory")
#define RESC(a) do { if (__any((a) < 1.f)) { if (hi == 0) al_l[r32] = (a); asm volatile("s_waitcnt lgkmcnt(0)" ::: "memory"); \
    for (int d = 0; d < 4; ++d) for (int r = 0; r < 16; ++r) o[d][r] *= al_l[crow(r, hi)]; } } while (0)
  f32x16 pA0, pA1, pB0, pB1; float alA, alB; bf16x8 pa0, pa1, pa2, pa3; const int NT = seq / KVBLK;
  constexpr int SE = 0, SO = 1;
  SLOAD(SE, 0); asm volatile("s_waitcnt vmcnt(0)" ::: "memory"); SWRITE(0, SE); __syncthreads();
  qkt(pA0, pA1, K_lds, qr, m_reg, r32, hi); partialSM(pA0, pA1, m_reg, alA, true);
  SLOAD(SO, KVBLK); if (2 < NT) SLOAD(SE, 2 * KVBLK);
  if (2 < NT) SWAIT(); else asm volatile("s_waitcnt vmcnt(0)" ::: "memory");
  SWRITE(1, SO); __syncthreads();
  for (int j = 1; j + 1 < NT; j += 2) {
    SBAR(); qkt(pB0, pB1, (bf16*)((char*)K_lds + SHM_K), qr, m_reg, r32, hi);
    finishSM(pA0, pA1, alA, l_reg, pa0, pa1, pa2, pa3); SBAR();
    SLOAD(SO, (j + 2) * KVBLK); SBAR();
    pv_d0(o, vb0, pa0, pa1, pa2, pa3); partialSM(pB0, pB1, m_reg, alB, false);
    __syncthreads(); SWAIT(); SWRITE(0, SE);
    RESC(alB); __syncthreads();
    SBAR(); qkt(pA0, pA1, K_lds, qr, m_reg, r32, hi);
    finishSM(pB0, pB1, alB, l_reg, pa0, pa1, pa2, pa3); SBAR();
    if (j + 3 < NT) SLOAD(SE, (j + 3) * KVBLK); SBAR();
    pv_d0(o, vb0 + (int)SHM_V, pa0, pa1, pa2, pa3); partialSM(pA0, pA1, m_reg, alA, false);
    __syncthreads(); if (j + 3 < NT) SWAIT(); else asm volatile("s_waitcnt vmcnt(0)" ::: "memory"); SWRITE(1, SO);
    RESC(alA); __syncthreads();
  }
  SBAR(); qkt(pB0, pB1, (bf16*)((char*)K_lds + SHM_K), qr, m_reg, r32, hi);
  finishSM(pA0, pA1, alA, l_reg, pa0, pa1, pa2, pa3); SBAR();
  pv_d0(o, vb0, pa0, pa1, pa2, pa3); partialSM(pB0, pB1, m_reg, alB, false);
  __syncthreads(); RESC(alB);
  finishSM(pB0, pB1, alB, l_reg, pa0, pa1, pa2, pa3); SBAR();
  pv_d0(o, vb0 + (int)SHM_V, pa0, pa1, pa2, pa3);
  if (hi == 0) li_l[r32] = l_reg; asm volatile("s_waitcnt lgkmcnt(0)" ::: "memory");
  float rli[16];
#pragma unroll
  for (int r = 0; r < 16; ++r) rli[r] = __builtin_amdgcn_rcpf(li_l[crow(r, hi)]);
  bf16* Ow = Ob + (long)(wid * QBLK) * LDO;
#pragma unroll
  for (int r = 0; r < 16; ++r) { const int orow = crow(r, hi);
#pragma unroll
    for (int d0 = 0; d0 < 4; d0 += 1) { const unsigned w = cvtpk(o[d0][r] * rli[r], 0.f); Ow[(long)orow * LDO + d0 * 32 + r32] = (bf16)(w & 0xffffu); } }
#undef SLOAD
#undef SWRITE
#undef SWAIT
#undef RESC
}
#undef KSWZ
#undef SBAR
}
constexpr size_t MiB = 1u << 20;
constexpr size_t WS_MOD = 0;
constexpr size_t WS_COS = 512 * 1024, WS_SIN = WS_COS + 8192;
constexpr size_t WS_BON = 1 * MiB;
constexpr size_t WS_HCTX = 8 * MiB;
constexpr size_t WS_W13A = 12 * MiB, WS_W2A = 23 * MiB, WS_W13B = 29 * MiB, WS_W2B = 40 * MiB, WS_WMIX = 46 * MiB, WS_G2T = 61 * MiB, WS_WO = 62 * MiB;
constexpr size_t WS_ARENA = 64 * MiB;
constexpr size_t WS_U = WS_ARENA;
constexpr size_t WS_ACT = WS_ARENA + 66 * MiB;
constexpr size_t WS_Q = WS_ARENA + 66 * MiB, WS_K = WS_Q + 66 * MiB, WS_V = WS_K + 66 * MiB, WS_O1 = WS_V + 66 * MiB;
constexpr size_t WS_A2 = WS_ARENA;
constexpr size_t WS_RKV = WS_ARENA + 132 * MiB;
constexpr size_t WS_L1 = WS_RKV + 198 * MiB;
constexpr size_t WS_GG = WS_ARENA;
constexpr size_t WS_Y0 = WS_ARENA + 66 * MiB;
constexpr size_t WS_Y1 = WS_L1 + 50 * MiB;
constexpr size_t WS_FO = WS_RKV;
constexpr size_t WS_END = 512 * MiB;
static_assert(WS_O1 + 132 * MiB <= WS_END && WS_Y1 + 66 * MiB <= WS_END && WS_ACT + 182 * MiB <= WS_END, "ws map");
constexpr size_t PLANE = (size_t)MTOK * 1024;

constexpr int RING_BYTES = 131072, LDS_BYTES = 147456;

typedef unsigned short bf16;
typedef unsigned v4u __attribute__((ext_vector_type(4)));
typedef unsigned v2u __attribute__((ext_vector_type(2)));
typedef float f32x4 __attribute__((ext_vector_type(4)));
typedef float f32x16 __attribute__((ext_vector_type(16)));
typedef short bf16x8 __attribute__((ext_vector_type(8)));
#define LAS __attribute__((address_space(3)))
__device__ __forceinline__ unsigned f2bf(float f) { unsigned u = __builtin_bit_cast(unsigned, f); return (u + 0x7fffu + ((u >> 16) & 1u)) >> 16; }
__device__ __forceinline__ unsigned pk2(float lo, float hi) { return pg8::cvt_pk_bf16(lo, hi); }
__device__ __forceinline__ float bflo(unsigned w) { return __builtin_bit_cast(float, w << 16); }
__device__ __forceinline__ float bfhi(unsigned w) { return __builtin_bit_cast(float, w & 0xffff0000u); }
__device__ __forceinline__ float wave_sum(float v) {
#pragma unroll
    for (int o = 1; o < 64; o <<= 1) v += __shfl_xor(v, o);
    return v;
}
__device__ __forceinline__ float sigm(float x) { return 1.0f / (1.0f + __expf(-x)); }
__device__ __forceinline__ float sigf(float x) { return __builtin_amdgcn_rcpf(1.0f + __expf(-x)); }

constexpr size_t WS_XBAR = 768 * 1024;
constexpr int LDS_XB = RING_BYTES + 256;
#define XB_TMO      128
#define XB_XCNT(j)  (256  + 64 * (j))
#define XB_XSUB(j)  (1280 + 64 * (j))
#define XB_XGEN(j)  (2304 + 64 * (j))
#define XB_TOP      3328
#define XB_TOPGEN   3392
#define XCD_BAR_WORDS 3456
#define XB_SPIN_CAP (1u << 18)

__device__ __forceinline__ unsigned xb_ld(unsigned* p)              { return __hip_atomic_load(p, __ATOMIC_RELAXED, __HIP_MEMORY_SCOPE_AGENT); }
__device__ __forceinline__ unsigned xb_add(unsigned* p, unsigned v) { return __hip_atomic_fetch_add(p, v, __ATOMIC_RELAXED, __HIP_MEMORY_SCOPE_AGENT); }
__device__ __forceinline__ unsigned xb_xcc_id() { return (unsigned)__builtin_amdgcn_s_getreg((3 << 11) | 20) & 0xFu; }
#define XB_SPIN(cond, bar) do { unsigned _sp = 0; while (cond) { __builtin_amdgcn_s_sleep(1); \
    if ((++_sp & 255u) == 0u) { if (xb_ld(&(bar)[XB_TMO])) break; if (_sp > XB_SPIN_CAP) { atomicAdd(&(bar)[XB_TMO], 1u); break; } } } } while (0)

struct XcdBarrier {
    unsigned* bar; unsigned x;
    volatile LAS unsigned* st;
};

__device__ __forceinline__ XcdBarrier xcd_barrier_post(unsigned* bar, volatile LAS unsigned* st) {
    XcdBarrier b; b.bar = bar; b.x = xb_xcc_id(); b.st = st;
    if (threadIdx.x == 0) (void)xb_add(&bar[XB_XCNT(b.x)], 1u);
    return b;
}
__device__ __forceinline__ void xcd_barrier_complete(unsigned* bar, unsigned x, unsigned& nloc, unsigned& nx) {
    const unsigned G = gridDim.x * gridDim.y * gridDim.z;
    unsigned sum, cnt, mine, sp = 0u;
    for (;;) {
        sum = 0u; cnt = 0u; mine = 0u;
#pragma unroll
        for (unsigned j = 0; j < 16; ++j) { const unsigned c = xb_ld(&bar[XB_XCNT(j)]); sum += c; cnt += (c > 0u) ? 1u : 0u; mine = (j == x) ? c : mine; }
        if (sum == G) break;
        __builtin_amdgcn_s_sleep(1);
        if ((++sp & 255u) == 0u) { if (xb_ld(&bar[XB_TMO])) break; if (sp > XB_SPIN_CAP) { atomicAdd(&bar[XB_TMO], 1u); break; } }
    }
    nloc = mine > 0u ? mine : 1u; nx = cnt > 0u ? cnt : 1u;
}

__device__ __forceinline__ void xcd_barrier(const XcdBarrier& b) {
    asm volatile("s_waitcnt vmcnt(0)" ::: "memory");
    __syncthreads();
    if (threadIdx.x == 0) {
        unsigned* bar = b.bar;
        __builtin_amdgcn_s_waitcnt(0);
        unsigned nloc = b.st[0], nx = b.st[1];
        if (nloc == 0u) { xcd_barrier_complete(bar, b.x, nloc, nx); b.st[0] = nloc; b.st[1] = nx; }
        const unsigned old = xb_add(&bar[XB_XSUB(b.x)], 1u);
        const unsigned gen = old / nloc;
        if (old + 1u == (gen + 1u) * nloc) {
            __builtin_amdgcn_fence(__ATOMIC_RELEASE, "agent");
            asm volatile("s_waitcnt vmcnt(0)" ::: "memory");
            const unsigned og = xb_add(&bar[XB_TOP], 1u);
            const unsigned tg = og / nx;
            if (og + 1u == (tg + 1u) * nx) xb_add(&bar[XB_TOPGEN], 1u);
            else XB_SPIN(xb_ld(&bar[XB_TOPGEN]) == tg, bar);
            __builtin_amdgcn_fence(__ATOMIC_ACQUIRE, "agent");
            xb_add(&bar[XB_XGEN(b.x)], 1u);
            asm volatile("s_waitcnt vmcnt(0)" ::: "memory");
        } else {
            XB_SPIN(xb_ld(&bar[XB_XGEN(b.x)]) == gen, bar);
            __builtin_amdgcn_fence(__ATOMIC_ACQUIRE, "agent");
            asm volatile("s_waitcnt vmcnt(0)" ::: "memory");
        }
    }
    __syncthreads();
}

struct Args {
    const float* in[30]; float* out; unsigned char* ws; int ph_lo, ph_hi;
};
typedef const __attribute__((address_space(4))) Args* KArgs;
__device__ __forceinline__ KArgs kargs() { KArgs p = (KArgs)__builtin_amdgcn_kernarg_segment_ptr(); asm volatile("" : "+s"(p)); return p; }
struct Ctx {
    int wave, G, bx, gw, NGW;
    LAS unsigned char* lds; unsigned char* ws; bf16* hlat; float* hctx; const float* mod;
};
#define TID tid_
#define LANE lane_
#define TID_INIT const int tid_ = tid_opaque(); const int lane_ = tid_ & 63; (void)lane_;

__device__ __forceinline__ void transpose_item(const float* W, int ldw, int k0, int n0, bf16* WT, int ldt, int drow0, int dk0, const float* kscale, LAS float* scr, int lane) {
#pragma unroll 8
    for (int i = 0; i < 32; ++i) { const int kk = 2 * i + (lane >> 5); float v = W[(size_t)(k0 + kk) * ldw + n0 + (lane & 31)]; if (kscale) v *= kscale[k0 + kk]; scr[kk * 33 + (lane & 31)] = v; }
    asm volatile("s_waitcnt lgkmcnt(0)" ::: "memory");
    const int c = lane & 7;
#pragma unroll
    for (int j = 0; j < 4; ++j) { const int n = (lane >> 3) + 8 * j; const LAS float* s = scr + (8 * c) * 33 + n;
        v4u o; o.x = pk2(s[0 * 33], s[1 * 33]); o.y = pk2(s[2 * 33], s[3 * 33]); o.z = pk2(s[4 * 33], s[5 * 33]); o.w = pk2(s[6 * 33], s[7 * 33]);
        *(v4u*)(WT + (size_t)(drow0 + n) * ldt + dk0 + k0 + 8 * c) = o; }
    asm volatile("s_waitcnt lgkmcnt(0)" ::: "memory");
}
__device__ __forceinline__ bool conv_job(int& it, const float* W, int K, int N, bf16* WT, int ldt, int row_off, int dk0, const float* kscale, int mapping, LAS float* scr, int lane) {
    const int nblk = N / 32, nit = (K / 64) * nblk;
    if (it >= nit) { it -= nit; return false; }
    const int kb = it / nblk, nb = it % nblk, n0 = nb * 32;
    int drow0 = row_off + n0;
    if (mapping == 1) { const int bj = n0 >= FF_ ? 1 : 0, hid = n0 - bj * FF_; drow0 = 256 * (hid >> 7) + 128 * bj + (hid & 127); }
    transpose_item(W, N, kb * 64, n0, WT, ldt, drow0, dk0, kscale, scr, lane);
    return true;
}
__device__ __forceinline__ void convert_layer_weights(KArgs a, const Ctx& C, int l) {
    TID_INIT
    LAS float* scr = (LAS float*)(C.lds + C.wave * 16384);
    bf16* w13a = (bf16*)(C.ws + WS_W13A); bf16* w2a = (bf16*)(C.ws + WS_W2A); bf16* w13b = (bf16*)(C.ws + WS_W13B); bf16* w2b = (bf16*)(C.ws + WS_W2B);
    bf16* wmix = (bf16*)(C.ws + WS_WMIX); bf16* wo = (bf16*)(C.ws + WS_WO); bf16* g2t = (bf16*)(C.ws + WS_G2T);
    const float* f13 = a->in[7] + (size_t)l * 2 * 1024 * 5632; const float* f2 = a->in[8] + (size_t)l * 2 * FF_ * 1024;
    const int NIT = 2 * (16 * 176 + 44 * 32) + (l == 0 ? (16 * 96 + 16 * 32) : (6 * 16 * 32 + 8 * 16 * 2 + 2 * 16 * 5 + 16 * 32));
    for (int it0 = C.gw; it0 < NIT; it0 += C.NGW) {
        int it = it0;
        if (conv_job(it, f13, 1024, 5632, w13a, 1024, 0, 0, nullptr, 1, scr, LANE)) continue;
        if (conv_job(it, f2, FF_, 1024, w2a, FF_, 0, 0, nullptr, 0, scr, LANE)) continue;
        if (conv_job(it, f13 + (size_t)1024 * 5632, 1024, 5632, w13b, 1024, 0, 0, nullptr, 1, scr, LANE)) continue;
        if (conv_job(it, f2 + (size_t)FF_ * 1024, FF_, 1024, w2b, FF_, 0, 0, nullptr, 0, scr, LANE)) continue;
        if (l == 0) {
            if (conv_job(it, a->in[9], 1024, 3072, wmix, 1024, 0, 0, nullptr, 0, scr, LANE)) continue;
            conv_job(it, a->in[10], 1024, 1024, wo, 1024, 0, 0, nullptr, 0, scr, LANE);
        } else {
            const float* mix = a->in[13]; bool done = false;
            for (int p = 0; p < 3 && !done; ++p) {
                if (conv_job(it, a->in[14] + (size_t)p * 1024 * 1024, 1024, 1024, wmix, 2048, p * 1024, 0, nullptr, 0, scr, LANE)) { done = true; break; }
                if (conv_job(it, a->in[14] + (size_t)p * 1024 * 1024, 1024, 1024, wmix, 2048, p * 1024, 1024, mix + p * 1024, 0, scr, LANE)) { done = true; break; }
            }
            if (done) continue;
            for (int z = 0; z < 2 && !done; ++z) {
                if (conv_job(it, a->in[16] + (size_t)z * 1024 * 64, 1024, 64, wmix, 2048, 3072 + 64 * z, 0, nullptr, 0, scr, LANE)) { done = true; break; }
                if (conv_job(it, a->in[16] + (size_t)z * 1024 * 64, 1024, 64, wmix, 2048, 3072 + 64 * z, 1024, mix + 3 * 1024, 0, scr, LANE)) { done = true; break; }
                if (conv_job(it, a->in[19] + (size_t)z * 1024 * 64, 1024, 64, wmix, 2048, 3328 + 64 * z, 0, nullptr, 0, scr, LANE)) { done = true; break; }
                if (conv_job(it, a->in[19] + (size_t)z * 1024 * 64, 1024, 64, wmix, 2048, 3328 + 64 * z, 1024, mix + 4 * 1024, 0, scr, LANE)) { done = true; break; }
            }
            if (done) continue;
            if (conv_job(it, a->in[21], 1024, 160, wmix, 2048, 3584, 0, nullptr, 0, scr, LANE)) continue;
            if (conv_job(it, a->in[21], 1024, 160, wmix, 2048, 3584, 1024, mix + 5 * 1024, 0, scr, LANE)) continue;
            conv_job(it, a->in[28], 1024, 1024, wo, 1024, 0, 0, nullptr, 0, scr, LANE);
        }
    }
    if (l == 1) {
        const int gt = C.gw * 64 + LANE, NT = C.NGW * 64;
        unsigned zz = 0u; asm volatile("" : "+v"(zz)); const v4u zero4 = (v4u){zz, zz, zz, zz};
        for (int i = gt; i < 352 * 256; i += NT) { const int r = i >> 8, ch = i & 255; const int row = r < 128 ? 3200 + r : (r < 256 ? 3456 + (r - 128) : 3744 + (r - 256));
            *(v4u*)(wmix + (size_t)row * 2048 + ch * 8) = zero4; }
        const float* g2 = a->in[22];
        for (int i = gt; i < 1024 * 32; i += NT) { const int ch = i >> 10, n = i & 1023; float v[8];
#pragma unroll
            for (int j = 0; j < 8; ++j) { const int k = ch * 8 + j; v[j] = k < 160 ? g2[(size_t)k * 1024 + n] : 0.f; }
            *(v4u*)(g2t + (size_t)n * 256 + ch * 8) = (v4u){pk2(v[0], v[1]), pk2(v[2], v[3]), pk2(v[4], v[5]), pk2(v[6], v[7])}; }
    }
}

__device__ __forceinline__ void adaln_phase(KArgs a, const Ctx& C) {
    TID_INIT
    LAS float* sS = (LAS float*)C.lds;
    LAS float* red = sS + 5 * 1024;
    for (int i = TID; i < 5 * 1024; i += 512) { const float x = i < 4096 ? a->in[1][i] : a->in[3][i - 4096]; sS[i] = x * sigm(x); }
    __syncthreads();
    float* mod = (float*)(C.ws + WS_MOD);
    for (int item = C.bx; item < 288; item += C.G) {
        const int l = item / 144, col = (item % 144) * 64 + LANE;
        const float* W = a->in[4] + (size_t)l * 1024 * 9216 + col;
        float acc[5] = {0.f, 0.f, 0.f, 0.f, 0.f};
        const int kb = 128 * C.wave;
#pragma unroll 8
        for (int k = 0; k < 128; ++k) { const float w = W[(size_t)(kb + k) * 9216];
#pragma unroll
            for (int b = 0; b < 5; ++b) acc[b] += sS[b * 1024 + kb + k] * w; }
#pragma unroll
        for (int b = 0; b < 5; ++b) red[(C.wave * 5 + b) * 64 + LANE] = acc[b];
        __syncthreads();
        if (C.wave < 5) { float s = 0.f;
#pragma unroll
            for (int w = 0; w < 8; ++w) s += red[(w * 5 + C.wave) * 64 + LANE];
            mod[(size_t)(l * 5 + C.wave) * 9216 + col] = s + a->in[5][(size_t)l * 9216 + col]; }
        __syncthreads();
    }
    if (C.bx == C.G - 1) {
        float* ct = (float*)(C.ws + WS_COS); float* st = (float*)(C.ws + WS_SIN);
        for (int i = TID; i < 2048; i += 512) { const int pos = i >> 4, f = i & 15;
            const float inv = exp2f(-(float)f * (1.0f / 16.0f) * 13.287712379549449f);
            const float ang = (float)pos * inv; const double rev = (double)ang * 0.15915494309189535; const float fr = (float)(rev - floor(rev));
            ct[i] = __builtin_amdgcn_cosf(fr); st[i] = __builtin_amdgcn_sinf(fr); }
    }
}

__device__ __forceinline__ void modnorm_phase(const Ctx& C, const float* hl32, const bf16* hlb, const float* hc, int nrows, const float* nw, const float* modl, int ishift, bf16* out, int ldo) {
    TID_INIT
    constexpr int NR = 4;
    for (int row0 = C.gw; row0 < nrows; row0 += NR * C.NGW) {
        f32x4 v[NR][4]; float ss[NR];
#pragma unroll
        for (int q = 0; q < NR; ++q) { const int row = row0 + q * C.NGW; ss[q] = 0.f;
            if (row < nrows) { const bool isctx = row >= MLAT;
                if (isctx || hl32) { const float* hr = isctx ? hc + (size_t)(row - MLAT) * 1024 : hl32 + (size_t)row * 1024;
#pragma unroll
                    for (int j = 0; j < 4; ++j) v[q][j] = *(const f32x4*)(hr + 4 * LANE + 256 * j); }
                else { const bf16* hr = hlb + (size_t)row * 1024;
#pragma unroll
                    for (int j = 0; j < 4; ++j) { const v2u w = *(const v2u*)(hr + 4 * LANE + 256 * j); const fl32x2_t a0 = unpkh(w.x), a1 = unpkh(w.y); v[q][j] = (f32x4){a0.x, a0.y, a1.x, a1.y}; } } }
            else {
#pragma unroll
                for (int j = 0; j < 4; ++j) v[q][j] = (f32x4){0.f, 0.f, 0.f, 0.f}; } }
#pragma unroll
        for (int q = 0; q < NR; ++q) {
#pragma unroll
            for (int j = 0; j < 4; ++j) ss[q] += (v[q][j].x * v[q][j].x + v[q][j].y * v[q][j].y) + (v[q][j].z * v[q][j].z + v[q][j].w * v[q][j].w);
            ss[q] = wave_sum(ss[q]); }
#pragma unroll
        for (int q = 0; q < NR; ++q) { const int row = row0 + q * C.NGW;
            if (row < nrows) { const int bb = row >= MLAT ? 4 : (row >> 13); const float* sh = modl + bb * 9216 + ishift * 1024; const float* sc = sh + 1024;
                const float rstd = 1.0f / sqrtf(ss[q] * (1.0f / 1024.0f) + 1e-6f); bf16* orow = out + (size_t)row * ldo;
#pragma unroll
                for (int j = 0; j < 4; ++j) { const int c = 4 * LANE + 256 * j; const f32x4 w = *(const f32x4*)(nw + c), s1 = *(const f32x4*)(sc + c), s0 = *(const f32x4*)(sh + c);
                    const f32x4 y = (v[q][j] * rstd * w) * (s1 + 1.0f) + s0; *(v2u*)(orow + c) = (v2u){pk2(y.x, y.y), pk2(y.z, y.w)}; } } }
    }
}
__device__ __forceinline__ void shift_phase(const Ctx& C, bf16* A) {
    TID_INIT
    for (int row = C.gw; row < MTOK; row += C.NGW) {
        int t, len; if (row < MLAT) { t = row & (T_ - 1); len = T_; } else { t = (row - MLAT) & (CTX_ - 1); len = CTX_; }
        const bf16* ur = A + (size_t)row * 2048;
#pragma unroll
        for (int j = 0; j < 2; ++j) { const int c = 8 * LANE + 512 * j;
            const v4u u0 = *(const v4u*)(ur + c); v4u up = (v4u){0u, 0u, 0u, 0u}, un = up;
            if (t > 0) up = *(const v4u*)(ur - 2048 + c);
            if (t < len - 1) un = *(const v4u*)(ur + 2048 + c);
            v4u o;
#pragma unroll
            for (int q = 0; q < 4; ++q) { const float lo = 0.5f * (bflo(up[q]) + bflo(un[q])) - bflo(u0[q]), hi = 0.5f * (bfhi(up[q]) + bfhi(un[q])) - bfhi(u0[q]); o[q] = pk2(lo, hi); }
            *(v4u*)((bf16*)ur + 1024 + c) = o; }
    }
}
__device__ __forceinline__ void attn_combine_phase(KArgs a, const Ctx& C, const bf16* O1, bf16* ao) {
    TID_INIT
    const float* lv = a->in[11];
    const float d1 = wave_sum(lv[LANE] * lv[64 + LANE]), d2 = wave_sum(lv[128 + LANE] * lv[192 + LANE]);
    const float lam_init = 0.2f, lam = expf(d1) - expf(d2) + lam_init;
    const int hh = LANE >> 3, sub = LANE & 7;
    float sw[16];
#pragma unroll
    for (int i = 0; i < 16; ++i) sw[i] = a->in[12][16 * sub + i] * (1.0f - lam_init);
    constexpr int NR = 2;
    for (int row0 = C.gw; row0 < MTOK; row0 += NR * C.NGW) {
        v4u a0[NR], a1[NR], b0[NR], b1[NR];
#pragma unroll
        for (int u = 0; u < NR; ++u) { const int row = row0 + u * C.NGW; const bf16* p = O1 + (size_t)(row < MTOK ? row : row0) * 2048 + 256 * hh + 16 * sub;
            a0[u] = *(const v4u*)p; a1[u] = *(const v4u*)(p + 8); b0[u] = *(const v4u*)(p + 128); b1[u] = *(const v4u*)(p + 136); }
#pragma unroll
        for (int u = 0; u < NR; ++u) { const int row = row0 + u * C.NGW;
            float d[16]; float ss = 0.f;
#pragma unroll
            for (int q = 0; q < 4; ++q) { const unsigned wa0 = a0[u][q], wb0 = b0[u][q], wa1 = a1[u][q], wb1 = b1[u][q];
                d[2 * q] = bflo(wa0) - lam * bflo(wb0); d[2 * q + 1] = bfhi(wa0) - lam * bfhi(wb0); d[8 + 2 * q] = bflo(wa1) - lam * bflo(wb1); d[8 + 2 * q + 1] = bfhi(wa1) - lam * bfhi(wb1); }
#pragma unroll
            for (int i = 0; i < 16; ++i) ss += d[i] * d[i];
            ss += __shfl_xor(ss, 1); ss += __shfl_xor(ss, 2); ss += __shfl_xor(ss, 4);
            const float r = 1.0f / sqrtf(ss * (1.0f / 128.0f) + 1e-5f);
            v4u o0, o1;
#pragma unroll
            for (int q = 0; q < 4; ++q) { o0[q] = pk2(d[2 * q] * r * sw[2 * q], d[2 * q + 1] * r * sw[2 * q + 1]); o1[q] = pk2(d[8 + 2 * q] * r * sw[8 + 2 * q], d[8 + 2 * q + 1] * r * sw[8 + 2 * q + 1]); }
            if (row < MTOK) { bf16* op = ao + (size_t)row * 1024 + 128 * hh + 16 * sub; *(v4u*)op = o0; *(v4u*)(op + 8) = o1; } }
    }
}
__device__ __forceinline__ void rwkv_finish_phase(KArgs a, const Ctx& C, int nrows) {
    TID_INIT
    const bf16* y0 = (const bf16*)(C.ws + WS_Y0); const bf16* y1 = (const bf16*)(C.ws + WS_Y1); const bf16* vv = (const bf16*)(C.ws + WS_RKV) + 2 * PLANE; const bf16* gg = (const bf16*)(C.ws + WS_GG);
    const float* bon = (const float*)(C.ws + WS_BON); bf16* fo = (bf16*)(C.ws + WS_FO);
    const int c0 = 16 * LANE, hd = LANE >> 2;
    float lw[16], lb[16];
#pragma unroll
    for (int i = 0; i < 16; ++i) { lw[i] = a->in[26][c0 + i]; lb[i] = a->in[27][c0 + i]; }
    constexpr int NR = 1;
    for (int row0 = C.gw; row0 < nrows; row0 += NR * C.NGW) {
        v4u P[NR][2], Q[NR][2], PV[NR][2], PG[NR][2]; float sbv[NR];
#pragma unroll
        for (int u = 0; u < NR; ++u) { const int row = row0 + u * C.NGW, rr = row < nrows ? row : row0; const size_t o = (size_t)rr * 1024 + c0;
#pragma unroll
            for (int h2 = 0; h2 < 2; ++h2) { P[u][h2] = *(const v4u*)(y0 + o + 8 * h2); Q[u][h2] = *(const v4u*)(y1 + o + 8 * h2); PV[u][h2] = *(const v4u*)(vv + o + 8 * h2); PG[u][h2] = *(const v4u*)(gg + o + 8 * h2); }
            sbv[u] = bon[(size_t)rr * 16 + hd] + bon[(size_t)MTOK * 16 + (size_t)rr * 16 + hd]; }
#pragma unroll
        for (int u = 0; u < NR; ++u) { const int row = row0 + u * C.NGW; const size_t o = (size_t)row * 1024 + c0;
            float y[16], v[16], g[16];
#pragma unroll
            for (int h2 = 0; h2 < 2; ++h2)
#pragma unroll
                for (int k = 0; k < 4; ++k) { const unsigned wp = P[u][h2][k], wq = Q[u][h2][k], wv = PV[u][h2][k], wg = PG[u][h2][k];
                    y[8 * h2 + 2 * k] = bflo(wp) + bflo(wq); y[8 * h2 + 2 * k + 1] = bfhi(wp) + bfhi(wq); v[8 * h2 + 2 * k] = bflo(wv); v[8 * h2 + 2 * k + 1] = bfhi(wv); g[8 * h2 + 2 * k] = bflo(wg); g[8 * h2 + 2 * k + 1] = bfhi(wg); }
            float s = 0.f;
#pragma unroll
            for (int i = 0; i < 16; ++i) s += y[i];
            s += __shfl_xor(s, 1); s += __shfl_xor(s, 2);
            const float mu = s * (1.0f / 64.0f); float q2 = 0.f;
#pragma unroll
            for (int i = 0; i < 16; ++i) { y[i] -= mu; q2 += y[i] * y[i]; }
            q2 += __shfl_xor(q2, 1); q2 += __shfl_xor(q2, 2);
            const float rs = 1.0f / sqrtf(q2 * (1.0f / 64.0f) + 64e-5f), sb = sbv[u];
            v4u o0, o1;
#pragma unroll
            for (int k = 0; k < 4; ++k) {
                const float e0 = (y[2 * k] * rs * lw[2 * k] + lb[2 * k] + sb * v[2 * k]) * g[2 * k], e1 = (y[2 * k + 1] * rs * lw[2 * k + 1] + lb[2 * k + 1] + sb * v[2 * k + 1]) * g[2 * k + 1];
                const float f0 = (y[8 + 2 * k] * rs * lw[8 + 2 * k] + lb[8 + 2 * k] + sb * v[8 + 2 * k]) * g[8 + 2 * k], f1 = (y[9 + 2 * k] * rs * lw[9 + 2 * k] + lb[9 + 2 * k] + sb * v[9 + 2 * k]) * g[9 + 2 * k];
                o0[k] = pk2(e0, e1); o1[k] = pk2(f0, f1); }
            if (row < nrows) { *(v4u*)(fo + o) = o0; *(v4u*)(fo + o + 8) = o1; } }
    }
}
__device__ __forceinline__ void final_norm_phase(KArgs a, const Ctx& C) {
    TID_INIT
    const float* nw = a->in[29]; const bf16* hb = (const bf16*)(C.ws + WS_U); float* out = a->out;
    constexpr int NR = 4;
    for (int row0 = C.gw; row0 < MLAT; row0 += NR * C.NGW) {
        f32x4 v[NR][4]; float ss[NR];
#pragma unroll
        for (int q = 0; q < NR; ++q) { const int row = row0 + q * C.NGW; ss[q] = 0.f; const bf16* hr = hb + (size_t)(row < MLAT ? row : row0) * 1024;
#pragma unroll
            for (int j = 0; j < 4; ++j) { const v2u w = *(const v2u*)(hr + 4 * LANE + 256 * j); const fl32x2_t a0 = unpkh(w.x), a1 = unpkh(w.y); v[q][j] = (f32x4){a0.x, a0.y, a1.x, a1.y}; } }
#pragma unroll
        for (int q = 0; q < NR; ++q) {
#pragma unroll
            for (int j = 0; j < 4; ++j) ss[q] += (v[q][j].x * v[q][j].x + v[q][j].y * v[q][j].y) + (v[q][j].z * v[q][j].z + v[q][j].w * v[q][j].w);
            ss[q] = wave_sum(ss[q]); }
#pragma unroll
        for (int q = 0; q < NR; ++q) { const int row = row0 + q * C.NGW;
            if (row < MLAT) { const float rstd = 1.0f / sqrtf(ss[q] * (1.0f / 1024.0f) + 1e-6f);
#pragma unroll
                for (int j = 0; j < 4; ++j) { const int c = 4 * LANE + 256 * j; *(f32x4*)(out + (size_t)row * 1024 + c) = v[q][j] * rstd * *(const f32x4*)(nw + c); } } }
    }
}

__device__ __forceinline__ float dpp_red8(float v) {
    int x = __builtin_bit_cast(int, v);
    v += __builtin_bit_cast(float, __builtin_amdgcn_update_dpp(0, x, 0xB1, 0xF, 0xF, false)); x = __builtin_bit_cast(int, v);
    v += __builtin_bit_cast(float, __builtin_amdgcn_update_dpp(0, x, 0x4E, 0xF, 0xF, false)); x = __builtin_bit_cast(int, v);
    v += __builtin_bit_cast(float, __builtin_amdgcn_update_dpp(0, x, 0x141, 0xF, 0xF, false));
    return v;
}
__device__ __forceinline__ int scan_row(int z, int b, int s) {
    if (s < CTX_) return MLAT + b * CTX_ + (z ? CTX_ - 1 - s : s);
    const int sp = s - CTX_; return b * T_ + (z ? T_ - 1 - sp : sp);
}
__device__ __forceinline__ void scan_phase(KArgs a, const Ctx& C) {
    TID_INIT
    if (C.bx >= 128) return;
    const int z = C.bx >> 6, b = (C.bx >> 4) & 3, hd = C.bx & 15;
    const int tid = TID, lane = LANE, wave = C.wave;
    LAS float* Wd = (LAS float*)C.lds; LAS float* Kd = Wd + 2048; LAS float* Bb = Kd + 2048; LAS float* Aa = Bb + 2048; LAS float* Rr = Aa + 2048; LAS float* Vv = Rr + 2048;
    LAS float* Raw = Vv + 2048;
    LAS float* Yb = Raw + 4096;
    const bf16* rp = (const bf16*)(C.ws + WS_RKV); const bf16* kp = rp + PLANE; const bf16* vp = kp + PLANE; const bf16* L1 = (const bf16*)(C.ws + WS_L1);
    bf16* yout = (bf16*)(C.ws + (z ? WS_Y1 : WS_Y0)); float* bon = (float*)(C.ws + WS_BON) + (size_t)z * MTOK * 16;
    const int mat = (wave >> 1) & 1, nh = wave & 1, hi = lane >> 5, r32 = lane & 31;
    bf16x8 bfrag[4];
    {
        const float* W2 = (mat ? a->in[20] : a->in[17]) + (size_t)z * 64 * 1024 + hd * 64 + 32 * nh + r32;
#pragma unroll
        for (int ks = 0; ks < 4; ++ks) { float t[8];
#pragma unroll
            for (int i = 0; i < 8; ++i) t[i] = W2[(size_t)(16 * ks + 8 * hi + i) * 1024];
            const v4u w = (v4u){pk2(t[0], t[1]), pk2(t[2], t[3]), pk2(t[4], t[5]), pk2(t[6], t[7])}; bfrag[ks] = __builtin_bit_cast(bf16x8, w); }
    }
    const int te = tid >> 4, j4 = (tid & 15) * 4, ch = hd * 64 + j4;
    const f32x4 kk_c = *(const f32x4*)(a->in[23] + ch), ka_c = *(const f32x4*)(a->in[24] + ch), rk_c = *(const f32x4*)(a->in[25] + ch);
    const f32x4 w0_c = *(const f32x4*)(a->in[15] + z * 1024 + ch), a0_c = *(const f32x4*)(a->in[18] + z * 1024 + ch);
    const int ri = 8 * wave + (lane >> 3), j0 = 8 * (lane & 7);
    float S[8];
#pragma unroll
    for (int j = 0; j < 8; ++j) S[j] = 0.f;
    for (int c = 0; c < KVR / 32; ++c) {
        const int s0 = 32 * c;
        if (wave < 4) {
            const int row = scan_row(z, b, s0 + r32);
            const bf16* lp = L1 + (size_t)row * 768 + mat * 256 + 64 * z + 8 * hi;
            f32x16 acc = {};
#pragma unroll
            for (int ks = 0; ks < 4; ++ks) { const bf16x8 af = *(const bf16x8*)(lp + 16 * ks); acc = __builtin_amdgcn_mfma_f32_32x32x16_bf16(af, bfrag[ks], acc, 0, 0, 0); }
#pragma unroll
            for (int r = 0; r < 16; ++r) { const int t = (r & 3) + 8 * (r >> 2) + 4 * hi; Raw[mat * 2048 + t * 64 + 32 * nh + r32] = acc[r]; }
        }
        __syncthreads();
        {
            const int row = scan_row(z, b, s0 + te); const size_t o = (size_t)row * 1024 + ch;
            const v2u kb = *(const v2u*)(kp + o), rb = *(const v2u*)(rp + o), vb = *(const v2u*)(vp + o);
            const f32x4 k = (f32x4){bflo(kb.x), bfhi(kb.x), bflo(kb.y), bfhi(kb.y)}, r = (f32x4){bflo(rb.x), bfhi(rb.x), bflo(rb.y), bfhi(rb.y)}, v = (f32x4){bflo(vb.x), bfhi(vb.x), bflo(vb.y), bfhi(vb.y)};
            const f32x4 wr = *(const LAS f32x4*)(Raw + te * 64 + j4) + w0_c, ar = *(const LAS f32x4*)(Raw + 2048 + te * 64 + j4) + a0_c;
            f32x4 dec, aa;
#pragma unroll
            for (int j = 0; j < 4; ++j) { dec[j] = __expf(-0.6065306597126334f * sigm(wr[j])); aa[j] = sigm(ar[j]); }
            const f32x4 kkr = k * kk_c; float n2 = (kkr.x * kkr.x + kkr.y * kkr.y) + (kkr.z * kkr.z + kkr.w * kkr.w);
            n2 += __shfl_xor(n2, 1); n2 += __shfl_xor(n2, 2); n2 += __shfl_xor(n2, 4); n2 += __shfl_xor(n2, 8);
            const float inv = 1.0f / fmaxf(sqrtf(n2), 1e-12f);
            const f32x4 kk = kkr * inv, kdir = k * ((aa - 1.0f) * ka_c + 1.0f), bv = kk * aa;
            const f32x4 pb = r * kdir * rk_c; float sb = (pb.x + pb.y) + (pb.z + pb.w);
            sb += __shfl_xor(sb, 1); sb += __shfl_xor(sb, 2); sb += __shfl_xor(sb, 4); sb += __shfl_xor(sb, 8);
            if ((tid & 15) == 0) bon[(size_t)row * 16 + hd] = sb;
            const int lo = te * 64 + j4;
            *(LAS f32x4*)(Wd + lo) = dec; *(LAS f32x4*)(Kd + lo) = kdir; *(LAS f32x4*)(Bb + lo) = bv; *(LAS f32x4*)(Aa + lo) = -kk; *(LAS f32x4*)(Rr + lo) = r; *(LAS f32x4*)(Vv + lo) = v;
        }
        __syncthreads();
#pragma unroll 2
        for (int sl = 0; sl < 32; ++sl) {
            const int lo = sl * 64 + j0;
            const f32x4 w0 = *(const LAS f32x4*)(Wd + lo), w1 = *(const LAS f32x4*)(Wd + lo + 4), k0 = *(const LAS f32x4*)(Kd + lo), k1 = *(const LAS f32x4*)(Kd + lo + 4);
            const f32x4 b0 = *(const LAS f32x4*)(Bb + lo), b1 = *(const LAS f32x4*)(Bb + lo + 4), a0 = *(const LAS f32x4*)(Aa + lo), a1 = *(const LAS f32x4*)(Aa + lo + 4);
            const f32x4 r0 = *(const LAS f32x4*)(Rr + lo), r1 = *(const LAS f32x4*)(Rr + lo + 4); const float vi = Vv[sl * 64 + ri];
            float sa = ((S[0] * a0.x + S[1] * a0.y) + (S[2] * a0.z + S[3] * a0.w)) + ((S[4] * a1.x + S[5] * a1.y) + (S[6] * a1.z + S[7] * a1.w));
            sa = dpp_red8(sa);
            S[0] = S[0] * w0.x + (sa * b0.x + vi * k0.x); S[1] = S[1] * w0.y + (sa * b0.y + vi * k0.y); S[2] = S[2] * w0.z + (sa * b0.z + vi * k0.z); S[3] = S[3] * w0.w + (sa * b0.w + vi * k0.w);
            S[4] = S[4] * w1.x + (sa * b1.x + vi * k1.x); S[5] = S[5] * w1.y + (sa * b1.y + vi * k1.y); S[6] = S[6] * w1.z + (sa * b1.z + vi * k1.z); S[7] = S[7] * w1.w + (sa * b1.w + vi * k1.w);
            float y = ((S[0] * r0.x + S[1] * r0.y) + (S[2] * r0.z + S[3] * r0.w)) + ((S[4] * r1.x + S[5] * r1.y) + (S[6] * r1.z + S[7] * r1.w));
            y = dpp_red8(y);
            if ((lane & 7) == 0) Yb[sl * 64 + ri] = y;
        }
        __syncthreads();
        {
            const int row = scan_row(z, b, s0 + te); const f32x4 y = *(const LAS f32x4*)(Yb + te * 64 + j4);
            *(v2u*)(yout + (size_t)row * 1024 + ch) = (v2u){pk2(y.x, y.y), pk2(y.z, y.w)};
        }
    }
}


constexpr size_t WS_INVN = 5632 * 1024;
__device__ __forceinline__ void knorm_phase(KArgs a, const Ctx& C) {
    TID_INIT
    const bf16* kp = (const bf16*)(C.ws + WS_RKV) + PLANE; float* invn = (float*)(C.ws + WS_INVN);
    const int c0 = 16 * LANE; float kk[16];
#pragma unroll
    for (int i = 0; i < 16; ++i) kk[i] = a->in[23][c0 + i];
    for (int row = C.gw; row < MTOK; row += C.NGW) {
        const v4u p0 = *(const v4u*)(kp + (size_t)row * 1024 + c0), p1 = *(const v4u*)(kp + (size_t)row * 1024 + c0 + 8); float s = 0.f;
#pragma unroll
        for (int q = 0; q < 4; ++q) { const float x0 = bflo(p0[q]) * kk[2 * q], x1 = bfhi(p0[q]) * kk[2 * q + 1], x2 = bflo(p1[q]) * kk[8 + 2 * q], x3 = bfhi(p1[q]) * kk[9 + 2 * q]; s += (x0 * x0 + x1 * x1) + (x2 * x2 + x3 * x3); }
        s += __shfl_xor(s, 1); s += __shfl_xor(s, 2);
        if ((LANE & 3) == 0) invn[(size_t)row * 16 + (LANE >> 2)] = 1.0f / fmaxf(sqrtf(s), 1e-12f);
    }
}
constexpr int SC_RAW = 0, SC_BCB = 32768, SC_BCSZ = 18432, SC_AR = 0, SC_BK = 4608, SC_BKH = 9216, SC_VT = 14336, SC_GC = 17408, SC_BONP = 17664;
constexpr int SC_MB = SC_BCB + 3 * SC_BCSZ, SC_MSZ = 4096, SC_MAB = 0, SC_MK = 1024, SC_MBB = 2560, SC_W2F = SC_MB + 2 * SC_MSZ;
static_assert(SC_W2F + 16384 <= RING_BYTES, "scan LDS map");
__device__ __forceinline__ float dpp_red16(float v) {
    int x = __builtin_bit_cast(int, v);
    v += __builtin_bit_cast(float, __builtin_amdgcn_update_dpp(0, x, 0xB1, 0xF, 0xF, false)); x = __builtin_bit_cast(int, v);
    v += __builtin_bit_cast(float, __builtin_amdgcn_update_dpp(0, x, 0x4E, 0xF, 0xF, false)); x = __builtin_bit_cast(int, v);
    v += __builtin_bit_cast(float, __builtin_amdgcn_update_dpp(0, x, 0x141, 0xF, 0xF, false)); x = __builtin_bit_cast(int, v);
    v += __builtin_bit_cast(float, __builtin_amdgcn_update_dpp(0, x, 0x140, 0xF, 0xF, false));
    return v;
}
#define SC_BAR() asm volatile("s_waitcnt lgkmcnt(0)\n\ts_barrier" ::: "memory")
__device__ __forceinline__ void scan2_phase(KArgs a, const Ctx& C) {
    TID_INIT
    if (C.bx >= 128) return;
    const int z = C.bx >> 6, b = (C.bx >> 4) & 3, hd = C.bx & 15;
    const int lane = LANE, wave = C.wave, hi = lane >> 5, r32 = lane & 31;
    LAS unsigned char* L = C.lds;
    const bf16* rp = (const bf16*)(C.ws + WS_RKV); const bf16* kp = rp + PLANE; const bf16* vp = kp + PLANE; const bf16* L1 = (const bf16*)(C.ws + WS_L1);
    const float* invn = (const float*)(C.ws + WS_INVN);
    bf16* yout = (bf16*)(C.ws + (z ? WS_Y1 : WS_Y0)); float* bon = (float*)(C.ws + WS_BON) + (size_t)z * MTOK * 16;
    constexpr int NCH = KVR / 16;
    for (int f = wave; f < 16; f += 8) { const int mat = f >> 3, nh = (f >> 2) & 1, ks = f & 3;
        const float* W2 = (mat ? a->in[20] : a->in[17]) + (size_t)z * 64 * 1024 + hd * 64 + 32 * nh + r32; float t[8];
#pragma unroll
        for (int i = 0; i < 8; ++i) t[i] = W2[(size_t)(16 * ks + 8 * hi + i) * 1024];
        *(LAS v4u*)(L + SC_W2F + f * 1024 + lane * 16) = (v4u){pk2(t[0], t[1]), pk2(t[2], t[3]), pk2(t[4], t[5]), pk2(t[6], t[7])}; }
    for (int i = TID; i < 2 * 16 * 12; i += 512) { const int bb = i / 192, rem = i % 192; *(LAS unsigned*)(L + SC_MB + bb * SC_MSZ + SC_MBB + (rem / 12) * 48 + (rem % 12) * 4) = 0u; }
    f32x16 S0 = {}, S1 = {};
    const int role = wave < 2 ? 0 : (wave == 4 ? 1 : (wave == 5 ? 2 : 3));
    const int jj = lane & 15, tq = lane >> 4, wq = (wave & 1) | ((wave >> 2) << 1), jch = 16 * wq + jj, ch = hd * 64 + jch;
    const float kkc = a->in[23][ch], kac = a->in[24][ch], rkc = a->in[25][ch], w0c = a->in[15][z * 1024 + ch], a0c = a->in[18][z * 1024 + ch];
    const int pj2 = 2 * ((jch & ~12) | ((jch & 4) << 1) | ((jch & 8) >> 1));
    v4u lf[4];
#define PK_(e) lf[e].x
#define PR_(e) lf[e].y
#define PV_(e) lf[e].z
#define PIN_(e) lf[e].w
    const int p0_ = z ? 15 - 4 * tq : 4 * tq, pst_ = z ? -1 : 1;
#define SC_PREFETCH(qq) do { const int rmin_ = z ? scan_row(z, b, 16 * (qq) + 15) : scan_row(z, b, 16 * (qq)); const bf16* kb_ = kp + (size_t)rmin_ * 1024; const bf16* rb2_ = rp + (size_t)rmin_ * 1024; const bf16* vb_ = vp + (size_t)rmin_ * 1024; const float* ib2_ = invn + (size_t)rmin_ * 16 + hd; \
        _Pragma("unroll") for (int e = 0; e < 4; ++e) { const unsigned pe_ = (unsigned)(p0_ + pst_ * e), o_ = pe_ * 1024u + (unsigned)ch; PK_(e) = kb_[o_]; PR_(e) = rb2_[o_]; PV_(e) = vb_[o_]; PIN_(e) = __float_as_uint(ib2_[pe_ * 16u]); } } while (0)
    SC_BAR();
    if (role == 3) {
        SC_PREFETCH(0);
    } else if (role == 2) {
        const int row = scan_row(z, b, r32);
#pragma unroll
        for (int ks = 0; ks < 4; ++ks) lf[ks] = *(const v4u*)(L1 + (size_t)row * 768 + 64 * z + 16 * ks + 8 * hi);
    }
#pragma unroll 1
    for (int n = -4; n < NCH; ++n) {
        if (role == 0) {
            if (n >= 0) {
                LAS unsigned char* B = L + SC_BCB + (n % 3) * SC_BCSZ; LAS unsigned char* Mb = L + SC_MB + (n & 1) * SC_MSZ;
                bf16x8 Sb[4];
#pragma unroll
                for (int ks = 0; ks < 4; ++ks) { v4u w;
#pragma unroll
                    for (int e2 = 0; e2 < 4; ++e2) { const int r = 8 * (ks & 1) + 2 * e2; w[e2] = (ks < 2) ? pk2(S0[r], S0[r + 1]) : pk2(S1[r], S1[r + 1]); }
                    Sb[ks] = __builtin_bit_cast(bf16x8, w); }
                f32x16 acc = {};
#pragma unroll
                for (int ks = 0; ks < 4; ++ks) { const bf16x8 af = *(const LAS bf16x8*)(B + SC_AR + r32 * 144 + 32 * ks + 16 * hi); acc = __builtin_amdgcn_mfma_f32_32x32x16_bf16(af, Sb[ks], acc, 0, 0, 0); }
                const bf16x8 Vf = *(const LAS bf16x8*)(B + SC_VT + (32 * wave + r32) * 48 + 16 * hi);
                { const bf16x8 mk = *(const LAS bf16x8*)(Mb + SC_MK + r32 * 48 + 16 * hi); acc = __builtin_amdgcn_mfma_f32_32x32x16_bf16(mk, Vf, acc, 0, 0, 0); }
                float X[16];
#pragma unroll
                for (int r = 0; r < 8; ++r) { float xa = acc[r], xb = acc[r];
                    asm volatile("s_nop 1\n\tv_permlane32_swap_b32 %0, %1" : "+v"(xa), "+v"(xb));
                    const int t0 = (r & 3) + 8 * (r >> 2); X[t0] = xa; X[t0 + 4] = xb; }
                float ev[16];
#pragma unroll
                for (int qb = 0; qb < 4; ++qb) {
                    const f32x4 m1 = *(const LAS f32x4*)(Mb + SC_MAB + (4 * qb + 1) * 64 + qb * 16), m2 = *(const LAS f32x4*)(Mb + SC_MAB + (4 * qb + 2) * 64 + qb * 16), m3 = *(const LAS f32x4*)(Mb + SC_MAB + (4 * qb + 3) * 64 + qb * 16);
                    const float e0 = X[4 * qb]; const float e1 = X[4 * qb + 1] + m1.x * e0; const float e2 = X[4 * qb + 2] + (m2.x * e0 + m2.y * e1); const float e3 = X[4 * qb + 3] + ((m3.x * e0 + m3.y * e1) + m3.z * e2);
                    ev[4 * qb] = e0; ev[4 * qb + 1] = e1; ev[4 * qb + 2] = e2; ev[4 * qb + 3] = e3;
#pragma unroll
                    for (int t = 4 * qb + 4; t < 16; ++t) { const f32x4 mt = *(const LAS f32x4*)(Mb + SC_MAB + t * 64 + qb * 16); X[t] += (mt.x * e0 + mt.y * e1) + (mt.z * e2 + mt.w * e3); }
                    __builtin_amdgcn_sched_barrier(0); }
                v4u ew;
#pragma unroll
                for (int e2 = 0; e2 < 4; ++e2) { float x0 = ev[2 * e2], x1 = ev[2 * e2 + 1], x2 = ev[8 + 2 * e2], x3 = ev[9 + 2 * e2]; asm volatile("" : "+v"(x0), "+v"(x1), "+v"(x2), "+v"(x3));
                    ew[e2] = pk2(hi ? x2 : x0, hi ? x3 : x1); }
                const bf16x8 Eb = __builtin_bit_cast(bf16x8, ew);
                { const bf16x8 mb = *(const LAS bf16x8*)(Mb + SC_MBB + r32 * 48 + 16 * hi); acc = __builtin_amdgcn_mfma_f32_32x32x16_bf16(mb, Eb, acc, 0, 0, 0); }
#pragma unroll
                for (int r = 8; r < 16; ++r) { const int t = (r & 3) + 8 * ((r - 8) >> 2) + 4 * hi; const unsigned yo = (unsigned)(z ? 15 - t : t) * 1024u + (unsigned)r32;
                    const int rmin = z ? scan_row(z, b, 16 * n + 15) : scan_row(z, b, 16 * n); (yout + (size_t)rmin * 1024 + hd * 64 + 32 * wave)[yo] = (bf16)f2bf(acc[r]); }
#pragma unroll
                for (int q = 0; q < 4; ++q) { const f32x4 g0 = *(const LAS f32x4*)(B + SC_GC + (8 * q + 4 * hi) * 4), g1 = *(const LAS f32x4*)(B + SC_GC + (32 + 8 * q + 4 * hi) * 4);
#pragma unroll
                    for (int e = 0; e < 4; ++e) { S0[4 * q + e] *= g0[e]; S1[4 * q + e] *= g1[e]; } }
                { const bf16x8 a00 = *(const LAS bf16x8*)(B + SC_BKH + r32 * 80 + 16 * hi), a01 = *(const LAS bf16x8*)(B + SC_BKH + r32 * 80 + 32 + 16 * hi);
                  const bf16x8 a10 = *(const LAS bf16x8*)(B + SC_BKH + (32 + r32) * 80 + 16 * hi), a11 = *(const LAS bf16x8*)(B + SC_BKH + (32 + r32) * 80 + 32 + 16 * hi);
                  S0 = __builtin_amdgcn_mfma_f32_32x32x16_bf16(a00, Eb, S0, 0, 0, 0); S0 = __builtin_amdgcn_mfma_f32_32x32x16_bf16(a01, Vf, S0, 0, 0, 0);
                  S1 = __builtin_amdgcn_mfma_f32_32x32x16_bf16(a10, Eb, S1, 0, 0, 0); S1 = __builtin_amdgcn_mfma_f32_32x32x16_bf16(a11, Vf, S1, 0, 0, 0); }
            }
        } else if (role == 1) {
            const int mc = n + 1;
            if (mc >= 0 && mc < NCH) {
                LAS unsigned char* B = L + SC_BCB + (mc % 3) * SC_BCSZ; LAS unsigned char* Mb = L + SC_MB + (mc & 1) * SC_MSZ;
                f32x16 acc = {};
#pragma unroll
                for (int ks = 0; ks < 4; ++ks) { const bf16x8 af = *(const LAS bf16x8*)(B + SC_AR + r32 * 144 + 32 * ks + 16 * hi), bfr = *(const LAS bf16x8*)(B + SC_BK + r32 * 144 + 32 * ks + 16 * hi);
                    acc = __builtin_amdgcn_mfma_f32_32x32x16_bf16(af, bfr, acc, 0, 0, 0); }
#pragma unroll
                for (int r = 0; r < 16; ++r) { const int tp = (r & 3) + 8 * (r >> 2) + 4 * hi; const float v = acc[r];
                    if (r32 < 16) { if (tp < 16) *(LAS float*)(Mb + SC_MAB + tp * 64 + r32 * 4) = (r32 < tp) ? v : 0.f;
                                    else *(LAS bf16*)(Mb + SC_MBB + tp * 48 + r32 * 2) = (bf16)f2bf((r32 <= tp - 16) ? v : 0.f); }
                    else { const int tau = r32 - 16; const bool keep = tp < 16 ? (tau < tp) : (tau <= tp - 16); *(LAS bf16*)(Mb + SC_MK + tp * 48 + tau * 2) = (bf16)f2bf(keep ? v : 0.f); } }
                if (lane < 16) { const f32x4 p = *(const LAS f32x4*)(B + SC_BONP + lane * 16); bon[(size_t)scan_row(z, b, 16 * mc + lane) * 16 + hd] = (p.x + p.y) + (p.z + p.w); }
            }
        } else if (role == 2) {
            const int mat = (n + 4) & 1, p = (n + 4 - mat) >> 1;
            if (32 * p < KVR) {
                f32x16 a0 = {}, a1 = {};
#pragma unroll
                for (int ks = 0; ks < 4; ++ks) asm volatile("" : "+v"(lf[ks]));
#pragma unroll
                for (int ks = 0; ks < 4; ++ks) { const bf16x8 af = __builtin_bit_cast(bf16x8, lf[ks]);
                    const bf16x8 b0 = *(const LAS bf16x8*)(L + SC_W2F + ((mat * 2 + 0) * 4 + ks) * 1024 + lane * 16), b1 = *(const LAS bf16x8*)(L + SC_W2F + ((mat * 2 + 1) * 4 + ks) * 1024 + lane * 16);
                    a0 = __builtin_amdgcn_mfma_f32_32x32x16_bf16(af, b0, a0, 0, 0, 0); a1 = __builtin_amdgcn_mfma_f32_32x32x16_bf16(af, b1, a1, 0, 0, 0); }
                LAS float* Raw = (LAS float*)(L + SC_RAW + (p & 1) * 16384 + mat * 8192);
#pragma unroll
                for (int r = 0; r < 16; ++r) { const int t = (r & 3) + 8 * (r >> 2) + 4 * hi; Raw[t * 64 + r32] = a0[r]; Raw[t * 64 + 32 + r32] = a1[r]; }
            }
            { const int n2 = n + 1, mat2 = (n2 + 4) & 1, p2 = (n2 + 4 - mat2) >> 1;
              if (32 * p2 < KVR) { const int row = scan_row(z, b, 32 * p2 + r32);
#pragma unroll
                  for (int ks = 0; ks < 4; ++ks) lf[ks] = *(const v4u*)(L1 + (size_t)row * 768 + mat2 * 256 + 64 * z + 16 * ks + 8 * hi); } }
        } else {
            const int q = n + 2;
            if (q >= 0 && q < NCH) {
                LAS unsigned char* B = L + SC_BCB + (q % 3) * SC_BCSZ;
                const LAS float* Raw = (const LAS float*)(L + SC_RAW + ((q >> 1) & 1) * 16384) + (16 * (q & 1) + 4 * tq) * 64 + jch;
                float ewv[4], av[4], bv[4], kd[4], rv[4], bs[4];
#pragma unroll
                for (int e = 0; e < 4; ++e) asm volatile("" : "+v"(lf[e]));
#pragma unroll
                for (int e = 0; e < 4; ++e) { const unsigned kb_ = PK_(e), rb_ = PR_(e), ib_ = PIN_(e); const float kv = bflo(kb_), pin_e = __uint_as_float(ib_); rv[e] = bflo(rb_);
                    const float wr = Raw[e * 64] + w0c, ar = Raw[2048 + e * 64] + a0c;
                    ewv[e] = 0.6065306597126334f * sigf(wr); const float aa = sigf(ar), kk = kv * kkc * pin_e;
                    av[e] = -kk; bv[e] = kk * aa; kd[e] = kv * ((aa - 1.0f) * kac + 1.0f); bs[e] = rv[e] * kd[e] * rkc; }
                const unsigned v0_ = PV_(0), v1_ = PV_(1), v2_ = PV_(2), v3_ = PV_(3); v2u vt; vt.x = v0_ | (v1_ << 16); vt.y = v2_ | (v3_ << 16);
                *(LAS v2u*)(B + SC_VT + jch * 48 + 8 * tq) = vt;
                if (q + 1 < NCH) SC_PREFETCH(q + 1);
                const float loc = (ewv[0] + ewv[1]) + (ewv[2] + ewv[3]);
                float pa_ = loc, pb_ = loc;
                asm volatile("s_nop 1\n\tv_permlane16_swap_b32 %0, %1" : "+v"(pa_), "+v"(pb_));
                const float pair_ = pa_ + pb_; float pc_ = pair_, pd_ = pair_;
                asm volatile("s_nop 1\n\tv_permlane32_swap_b32 %0, %1" : "+v"(pc_), "+v"(pd_));
                const float excl = ((tq & 1) ? pa_ : 0.f) + ((tq & 2) ? pc_ : 0.f);
                const float LC = pc_ + pd_, gC = __expf(-LC);
                float Lp = excl; float gprev = __expf(-Lp);
                float bh[4], kh[4];
#pragma unroll
                for (int e = 0; e < 4; ++e) { const float Le = Lp + ewv[e], g = __expf(-Le), ig = __builtin_amdgcn_rcpf(g); const int t = 4 * tq + e;
                    const unsigned par = pk2(gprev * av[e], g * rv[e]);
                    *(LAS bf16*)(B + SC_AR + t * 144 + pj2) = (bf16)(par & 0xffffu); *(LAS bf16*)(B + SC_AR + (16 + t) * 144 + pj2) = (bf16)(par >> 16);
                    const float bt = bv[e] * ig, kt = kd[e] * ig; const unsigned pbk = pk2(bt, kt);
                    *(LAS bf16*)(B + SC_BK + t * 144 + pj2) = (bf16)(pbk & 0xffffu); *(LAS bf16*)(B + SC_BK + (16 + t) * 144 + pj2) = (bf16)(pbk >> 16);
                    bh[e] = bt * gC; kh[e] = kt * gC; Lp = Le; gprev = g; }
                *(LAS v2u*)(B + SC_BKH + jch * 80 + 8 * tq) = (v2u){pk2(bh[0], bh[1]), pk2(bh[2], bh[3])};
                *(LAS v2u*)(B + SC_BKH + jch * 80 + 32 + 8 * tq) = (v2u){pk2(kh[0], kh[1]), pk2(kh[2], kh[3])};
                if (tq == 3) *(LAS float*)(B + SC_GC + jch * 4) = gC;
#pragma unroll
                for (int e = 0; e < 4; ++e) { const float s = dpp_red16(bs[e]); if (jj == 0) *(LAS float*)(B + SC_BONP + (4 * tq + e) * 16 + wq * 4) = s; }
            }
        }
        SC_BAR();
    }
}

__device__ __forceinline__ void attention_phase(const Ctx& C, char* lds_generic) {
    using abf = attn2::bf16;
    const abf* Q = (const abf*)(C.ws + WS_Q); const abf* K = (const abf*)(C.ws + WS_K); const abf* V = (const abf*)(C.ws + WS_V); abf* O1 = (abf*)(C.ws + WS_O1);
    const int vcu = (C.G % 8 == 0) ? (C.bx % 8) * (C.G / 8) + C.bx / 8 : C.bx;
#pragma unroll 1
    for (int it = vcu; it < 2048 + 64; it += C.G) {
        const abf *Qb, *Kh, *Vh; abf* Ob; int seq;
        if (it < 2048) {
            int id = it; if (2048 % C.G == 0) id = (it % C.G) * (2048 / C.G) + it / C.G;
            int bs = id >> 5, qb = id & 31;
            if (C.G == 256) { const int v_ = it & 255, r_ = it >> 8; bs = 8 * (v_ >> 5) + r_; qb = v_ & 31; }
            const int b = bs >> 4, s = bs & 15;
            Qb = Q + ((size_t)b * T_ + (size_t)qb * 256) * 1024 + s * 64; Kh = K + (size_t)b * KVR * 1024 + s * 64; Vh = V + (size_t)b * KVR * 1024 + (s >> 1) * 128;
            Ob = O1 + ((size_t)b * T_ + (size_t)qb * 256) * 2048 + s * 128; seq = KVR;
        } else {
            const int id = it - 2048, b = id >> 4, s = id & 15;
            Qb = Q + ((size_t)MLAT + (size_t)b * CTX_) * 1024 + s * 64; Kh = K + ((size_t)b * KVR + T_) * 1024 + s * 64; Vh = V + ((size_t)b * KVR + T_) * 1024 + (s >> 1) * 128;
            Ob = O1 + ((size_t)MLAT + (size_t)b * CTX_) * 2048 + s * 128; seq = CTX_;
        }
        attn2::attn_dense_body(Qb, Kh, Vh, Ob, seq, lds_generic);
    }
}

template <class Epi> __device__ __forceinline__ void run_gemm(const Ctx& C, const bf16* A, int lda, const bf16* Bt, int M, int N, int K, const Epi& E) {
    pg8::Gemm g{A, Bt, M, N, K, lda, K}; pg8::StaticOrder S; S.init(M, N, C.G, C.bx);
#ifndef NO_GEMM
    pg8::gemm_phase<Epi, pg8::StaticOrder, true, true>(C.lds, g, S, E);
#endif
}

__device__ __forceinline__ Ctx make_ctx(KArgs ka, LAS unsigned char* lds) {
    Ctx C; C.wave = __builtin_amdgcn_readfirstlane(tid_opaque() >> 6); C.G = sgpr_opaque(gridDim.x); C.bx = sgpr_opaque(blockIdx.x); C.gw = C.bx * 8 + C.wave; C.NGW = C.G * 8; C.lds = lds;
    C.ws = ka->ws; C.hlat = (bf16*)ka->out; C.hctx = (float*)(C.ws + WS_HCTX); C.mod = (const float*)(C.ws + WS_MOD); return C;
}
__device__ __forceinline__ void run_gemm_ctx(const Ctx& C, const bf16* A, int lda, const bf16* Bt, int K, float* dst_ctx, const float* gate, float gs) {
    pg8::Gemm g{A, Bt, MTOK, 1024, K / 2, lda, K}; pg8::CtxSplitOrder S{C.bx, K};
    pg8::gemm_phase<pg8::EpiResAtomic, pg8::CtxSplitOrder, true, true>(C.lds, g, S, pg8::EpiResAtomic{dst_ctx, gate, gs});
}
__global__ void __launch_bounds__(512, 2) mega_fwd(Args args_unused) {
    extern __shared__ __attribute__((aligned(16))) unsigned char lds[];
    cg::grid_group grid = cg::this_grid();
    int ph = 0;
    tid_table_init();
    { if (threadIdx.x < 2) ((LAS unsigned*)((LAS unsigned char*)lds + LDS_XB))[threadIdx.x] = 0u; __syncthreads();
      const KArgs k0 = kargs(); (void)xcd_barrier_post((unsigned*)(k0->ws + WS_XBAR), (volatile LAS unsigned*)((LAS unsigned char*)lds + LDS_XB)); }
#define PHASE_BEGIN { const KArgs ka = kargs(); if (ka->ph_lo <= ph && ph < ka->ph_hi) { const Ctx C = make_ctx(ka, (LAS unsigned char*)lds); unsigned char* const ws = C.ws; \
        const float* const modl = C.mod + (size_t)l * 5 * 9216; const float* const nw = ka->in[6] + (size_t)l * 3 * 1024; (void)ws; (void)modl; (void)nw;
#define PHASE_END } } { const KArgs kb = kargs(); if (kb->ph_lo <= ph && ph + 1 < kb->ph_hi) { if (ph == 0) grid.sync(); else { XcdBarrier xb_; xb_.bar = (unsigned*)(kb->ws + WS_XBAR); xb_.x = xb_xcc_id(); xb_.st = (volatile LAS unsigned*)((LAS unsigned char*)lds + LDS_XB); xcd_barrier(xb_); } } } ++ph;
#define WPTR(off) ((bf16*)(ws + (off)))
    { const int l = 0; PHASE_BEGIN adaln_phase(ka, C); __syncthreads(); convert_layer_weights(ka, C, 0);
        { const int t_ = tid_opaque(); const f32x4* s_ = (const f32x4*)ka->in[2]; f32x4* d_ = (f32x4*)C.hctx; for (int i = C.bx * 512 + t_; i < MCTX * 1024 / 4; i += C.G * 512) d_[i] = s_[i]; }
        PHASE_END }

#pragma unroll 1
    for (int l = 0; l < 2; ++l) {
        PHASE_BEGIN modnorm_phase(C, l == 0 ? ka->in[0] : nullptr, C.hlat, l == 0 ? ka->in[2] : C.hctx, MTOK, nw, modl, 0, WPTR(WS_U), 1024); if (l == 1) convert_layer_weights(ka, C, 1); PHASE_END
        PHASE_BEGIN run_gemm(C, WPTR(WS_U), 1024, WPTR(WS_W13A), MTOK, 2 * FF_, 1024, pg8::EpiSwiglu{WPTR(WS_ACT), FF_}); PHASE_END
        PHASE_BEGIN run_gemm(C, WPTR(WS_ACT), FF_, WPTR(WS_W2A), MLAT, 1024, FF_, pg8::EpiRes{l == 0 ? ka->in[0] : nullptr, C.hlat, C.hlat, modl + 2 * 1024, 0.5f});
            run_gemm_ctx(C, WPTR(WS_ACT), FF_, WPTR(WS_W2A), FF_, C.hctx, modl + 2 * 1024, 0.5f); PHASE_END
        if (l == 0) {
            PHASE_BEGIN modnorm_phase(C, nullptr, C.hlat, C.hctx, MTOK, nw + 1024, modl, 3, WPTR(WS_U), 1024); PHASE_END
            PHASE_BEGIN run_gemm(C, WPTR(WS_U), 1024, WPTR(WS_WMIX), MTOK, 3072, 1024, pg8::EpiQKV{WPTR(WS_Q), WPTR(WS_K), WPTR(WS_V), (const float*)(ws + WS_COS), (const float*)(ws + WS_SIN), 0.125f * 1.4426950408889634f}); PHASE_END
            PHASE_BEGIN
#ifndef NO_ATT
            attention_phase(C, (char*)lds);
#endif
            PHASE_END
            PHASE_BEGIN attn_combine_phase(ka, C, WPTR(WS_O1), WPTR(WS_U)); PHASE_END
            PHASE_BEGIN run_gemm(C, WPTR(WS_U), 1024, WPTR(WS_WO), MLAT, 1024, 1024, pg8::EpiRes{nullptr, C.hlat, C.hlat, modl + 5 * 1024, 1.0f});
            run_gemm_ctx(C, WPTR(WS_U), 1024, WPTR(WS_WO), 1024, C.hctx, modl + 5 * 1024, 1.0f); PHASE_END
        } else {
            PHASE_BEGIN modnorm_phase(C, nullptr, C.hlat, C.hctx, MTOK, nw + 1024, modl, 3, WPTR(WS_A2), 2048); PHASE_END
            PHASE_BEGIN shift_phase(C, WPTR(WS_A2)); PHASE_END
            PHASE_BEGIN run_gemm(C, WPTR(WS_A2), 2048, WPTR(WS_WMIX), MTOK, 3840, 2048, pg8::EpiPlain{WPTR(WS_RKV), 1024, 1, PLANE, WPTR(WS_L1)}); PHASE_END
            PHASE_BEGIN run_gemm(C, WPTR(WS_L1) + 512, 768, WPTR(WS_G2T), MTOK, 1024, 256, pg8::EpiPlain{WPTR(WS_GG), 1024, 0, 0, nullptr}); knorm_phase(ka, C); PHASE_END
            PHASE_BEGIN
#ifndef NO_SCAN
#ifdef DUP_SCAN
#pragma unroll 1
            for (int rep_ = 0; rep_ < 2; ++rep_) { scan2_phase(ka, C); __syncthreads(); }
#else
            scan2_phase(ka, C);
#endif
#endif
            PHASE_END
            PHASE_BEGIN rwkv_finish_phase(ka, C, MLAT); PHASE_END
            PHASE_BEGIN run_gemm(C, WPTR(WS_FO), 1024, WPTR(WS_WO), MLAT, 1024, 1024, pg8::EpiRes{nullptr, C.hlat, C.hlat, modl + 5 * 1024, 1.0f}); PHASE_END
        }
        PHASE_BEGIN modnorm_phase(C, nullptr, C.hlat, C.hctx, l == 1 ? MLAT : MTOK, nw + 2048, modl, 6, WPTR(WS_U), 1024); PHASE_END
        PHASE_BEGIN run_gemm(C, WPTR(WS_U), 1024, WPTR(WS_W13B), l == 1 ? MLAT : MTOK, 2 * FF_, 1024, pg8::EpiSwiglu{WPTR(WS_ACT), FF_}); PHASE_END
        PHASE_BEGIN run_gemm(C, WPTR(WS_ACT), FF_, WPTR(WS_W2B), MLAT, 1024, FF_, pg8::EpiRes{nullptr, C.hlat, l == 1 ? WPTR(WS_U) : C.hlat, modl + 8 * 1024, 0.5f});
            if (l == 0) run_gemm_ctx(C, WPTR(WS_ACT), FF_, WPTR(WS_W2B), FF_, C.hctx, modl + 8 * 1024, 0.5f); PHASE_END
    }
    { const int l = 0; PHASE_BEGIN final_norm_phase(ka, C); PHASE_END }
}

#ifndef MK_PER_PHASE
#define MK_PER_PHASE 0
#endif
constexpr int N_PHASES = 1 + 11 + 13 + 1;
extern "C" void kernel_launch(void* const* d_in, const int* in_sizes, int n_in, void* d_out, int out_size, void* d_ws, size_t ws_size, hipStream_t stream) {
    static int grid = 0;
    if (grid == 0) {
        if (n_in != 30 || out_size != MLAT * 1024 || ws_size < WS_END) { fprintf(stderr, "kernel_launch: unexpected shapes (n_in %d out %d ws %zu)\n", n_in, out_size, ws_size); grid = -1; return; }
        int dev = 0, cus = 0, per_cu = 0;
        hipGetDevice(&dev); hipDeviceGetAttribute(&cus, hipDeviceAttributeMultiprocessorCount, dev);
        hipFuncSetAttribute((const void*)mega_fwd, hipFuncAttributeMaxDynamicSharedMemorySize, LDS_BYTES);
        hipOccupancyMaxActiveBlocksPerMultiprocessor(&per_cu, (const void*)mega_fwd, 512, LDS_BYTES);
        (void)hipGetLastError();
        if (per_cu < 1) per_cu = 1;
        grid = cus;
        if (grid > 256) grid = 256;
    }
    if (grid < 0) return;
    if (hipMemsetAsync((char*)d_ws + WS_XBAR, 0, 16384, stream) != hipSuccess) { fprintf(stderr, "kernel_launch: memset of the barrier words failed\n"); return; }
    Args a{};
    for (int i = 0; i < 30; ++i) a.in[i] = (const float*)d_in[i];
    a.out = (float*)d_out; a.ws = (unsigned char*)d_ws;
#ifdef DUP_PH
    a.ph_lo = 0; a.ph_hi = DUP_PH + 1;
    { void* kargs0[] = {&a}; (void)hipLaunchCooperativeKernel((const void*)mega_fwd, dim3(grid), dim3(512), kargs0, LDS_BYTES, stream); }
    (void)hipMemsetAsync((char*)d_ws + WS_XBAR, 0, 16384, stream);
    a.ph_lo = DUP_PH; a.ph_hi = N_PHASES;
#else
    a.ph_lo = 0; a.ph_hi = N_PHASES;
#endif
    void* kargs[] = {&a};
    hipError_t e = hipLaunchCooperativeKernel((const void*)mega_fwd, dim3(grid), dim3(512), kargs, LDS_BYTES, stream);
    if (e != hipSuccess) fprintf(stderr, "cooperative launch failed: %s (grid %d)\n", hipGetErrorString(e), grid);
}
```

```cpp
#include <hip/hip_runtime.h>
#include <hip/hip_cooperative_groups.h>
#include <hip/hip_bf16.h>
#include <cstdio>
#include <cstdint>
#include <cmath>
namespace cg = cooperative_groups;

constexpr int DM_ = 1024, NB_ = 4, T_ = 8192, CTX_ = 256, MLAT = NB_ * T_, MCTX = NB_ * CTX_, MTOK = MLAT + MCTX, FF_ = 2816, KVR = T_ + CTX_;
constexpr int NMODV = 9 * DM_;
constexpr int TID_TABLE = 131072 + 512;
__device__ __forceinline__ int hw_wave_slot() { return (int)__builtin_amdgcn_s_getreg((5 << 11) | 4); }
__device__ __forceinline__ void tid_table_init() { if ((threadIdx.x & 63) == 0) ((__attribute__((address_space(3))) int*)TID_TABLE)[hw_wave_slot()] = (int)(threadIdx.x >> 6); __syncthreads(); }
__device__ __forceinline__ int tid_opaque() { const int w = ((__attribute__((address_space(3))) int*)TID_TABLE)[hw_wave_slot()]; int t = w * 64 + (int)__builtin_amdgcn_mbcnt_hi(~0u, __builtin_amdgcn_mbcnt_lo(~0u, 0u)); asm volatile("" : "+v"(t)); return t; }
__device__ __forceinline__ int sgpr_opaque(int v) { asm volatile("" : "+s"(v)); return v; }
typedef _Float16 hf16x2_t __attribute__((ext_vector_type(2))); typedef float fl32x2_t __attribute__((ext_vector_type(2)));
__device__ __forceinline__ unsigned pkh(float a, float b) { fl32x2_t v = {a, b}; hf16x2_t x = __builtin_convertvector(v, hf16x2_t); return __builtin_bit_cast(unsigned, x); }
__device__ __forceinline__ fl32x2_t unpkh(unsigned w) { hf16x2_t x = __builtin_bit_cast(hf16x2_t, w); return __builtin_convertvector(x, fl32x2_t); }
namespace pg8 {
#define PG8_LAS __attribute__((address_space(3)))
typedef unsigned short bf16_t;
typedef short bf16x8 __attribute__((ext_vector_type(8)));
typedef float f32x4 __attribute__((ext_vector_type(4)));
typedef unsigned u32x4 __attribute__((ext_vector_type(4)));
constexpr int BM = 256, BK = 64, HALF = 128, HTB = HALF * BK * 2  , STAGE_BYTES = 8 * HTB, NXCD = 8, WGM = 8;

__host__ __device__ __forceinline__ int lds_byte(int r, int c) { const int st = (r >> 4) * 2 + (c >> 5), rr = r & 15, cc = c & 31, ob = rr * 64 + cc * 2; return st * 1024 + (ob ^ (((ob >> 9) & 1) << 5)); }
__host__ __device__ __forceinline__ void stage_rc(int b, int& R, int& C) { const int st = b / 1024, sb = b % 1024, swz = sb ^ (((sb >> 9) & 1) << 5); R = (st >> 1) * 16 + swz / 64; C = (st & 1) * 32 + (swz % 64) / 2; }
__host__ __device__ __forceinline__ int perm32(int rho) { const int n = rho >> 4, i = rho & 15; return 8 * (i >> 2) + 4 * n + (i & 3); }

struct Unit { int pm, pn, koff; };
struct Gemm { const bf16_t* A; const bf16_t* Bt; int M, N, K, lda, ldb; };

struct StaticOrder {
    int nM, nN, nwg, G, c;
    __host__ __device__ void init(int M, int N, int G_, int c_) { nM = M / BM; nN = N / BM; nwg = nM * nN; G = G_; c = c_; }
    __host__ __device__ bool next(int i, Unit& u) const {
        const long L = (long)i * G + c; if (L >= nwg) return false;
        int wgid = (int)L; { const int q = nwg / NXCD, r = nwg % NXCD, xcd = wgid % NXCD, off = wgid / NXCD; wgid = (xcd < r ? xcd * (q + 1) : r * (q + 1) + (xcd - r) * q) + off; }
        const int nig = WGM * nN, gid = wgid / nig, fm = gid * WGM, gsz = (nM - fm) < WGM ? (nM - fm) : WGM;
        u.pm = fm + ((wgid % nig) % gsz); u.pn = (wgid % nig) / gsz; u.koff = 0; return true;
    }
    __device__ __forceinline__ void a_ready(const Unit&) const {}
    __device__ __forceinline__ void done(const Unit&) const {}
};
struct CtxSplitOrder {
    int c, khalf_bytes;
    __host__ __device__ bool next(int i, Unit& u) const { if (i > 0 || c >= 32) return false; u.pm = 128 + (c >> 3); u.pn = (c >> 1) & 3; u.koff = (c & 1) * khalf_bytes; return true; }
    __device__ __forceinline__ void a_ready(const Unit&) const {}
    __device__ __forceinline__ void done(const Unit&) const {}
};

__device__ __forceinline__ unsigned cvt_pk_bf16(float lo, float hi) { unsigned r; asm volatile("v_cvt_pk_bf16_f32 %0, %1, %2" : "=v"(r) : "v"(lo), "v"(hi)); return r; }
typedef float f32x2 __attribute__((ext_vector_type(2)));
typedef unsigned u32x2 __attribute__((ext_vector_type(2)));
__device__ __forceinline__ float fast_sigmoid(float x) { return __builtin_amdgcn_rcpf(1.0f + __expf(-x)); }

struct EpiSwiglu {
    static constexpr bool PERM = true, AFTER_DRAIN = false;
    bf16_t* O; int ldc;
    __device__ __forceinline__ void operator()(const f32x4 (&acc)[2][2][4][2], const Unit& u, int wr, int wc, int fr, int fq) const {
        const int row0 = u.pm * BM + wr * 64 + fr, col0 = u.pn * HALF + wc * 32 + 8 * fq;
#pragma unroll
        for (int ai = 0; ai < 2; ++ai)
#pragma unroll
            for (int m = 0; m < 4; ++m) {
                bf16_t* rowp = O + (size_t)(row0 + ai * HALF + m * 16) * ldc + col0;
                float v[8];
#pragma unroll
                for (int n = 0; n < 2; ++n)
#pragma unroll
                    for (int j = 0; j < 4; ++j) { const float g = acc[ai][0][m][n][j], up = acc[ai][1][m][n][j]; v[n * 4 + j] = g * fast_sigmoid(g) * up; }
                u32x4 w; w.x = cvt_pk_bf16(v[0], v[1]); w.y = cvt_pk_bf16(v[2], v[3]); w.z = cvt_pk_bf16(v[4], v[5]); w.w = cvt_pk_bf16(v[6], v[7]);
                *(u32x4*)rowp = w;
            }
    }
};

struct EpiRes {
    static constexpr bool PERM = true, AFTER_DRAIN = false;
    const float* src_f32; const bf16_t* src_bf; bf16_t* dst; const float* gate;   float gs;
    __device__ __forceinline__ void operator()(const f32x4 (&acc)[2][2][4][2], const Unit& u, int wr, int wc, int fr, int fq) const {
        const int bb = u.pm >> 5; const size_t tb = (size_t)u.pm * BM * 1024; const int col0 = u.pn * BM + wc * 32 + 8 * fq;
        f32x4 gv[2][2];
#pragma unroll
        for (int bj = 0; bj < 2; ++bj)
#pragma unroll
            for (int n = 0; n < 2; ++n) gv[bj][n] = *(const f32x4*)(gate + bb * 9216 + col0 + bj * HALF + n * 4) * gs;
#pragma unroll
        for (int ai = 0; ai < 2; ++ai)
#pragma unroll
            for (int m = 0; m < 4; ++m) { const size_t off = tb + (size_t)(ai * HALF + wr * 64 + m * 16 + fr) * 1024 + col0;
#pragma unroll
                for (int bj = 0; bj < 2; ++bj) { f32x4 s0, s1;
                    if (src_f32) { s0 = *(const f32x4*)(src_f32 + off + bj * HALF); s1 = *(const f32x4*)(src_f32 + off + bj * HALF + 4); }
                    else { const u32x4 w = *(const u32x4*)(src_bf + off + bj * HALF);
                        const fl32x2_t a0 = unpkh(w.x), a1 = unpkh(w.y), a2 = unpkh(w.z), a3 = unpkh(w.w); s0 = (f32x4){a0.x, a0.y, a1.x, a1.y}; s1 = (f32x4){a2.x, a2.y, a3.x, a3.y}; }
                    const f32x4 r0 = s0 + gv[bj][0] * acc[ai][bj][m][0], r1 = s1 + gv[bj][1] * acc[ai][bj][m][1];
                    u32x4 o; o.x = pkh(r0[0], r0[1]); o.y = pkh(r0[2], r0[3]); o.z = pkh(r1[0], r1[1]); o.w = pkh(r1[2], r1[3]);
                    *(u32x4*)(dst + off + bj * HALF) = o; } }
    }
};

struct EpiQKV {
    static constexpr bool PERM = false, AFTER_DRAIN = false;
    bf16_t* Q; bf16_t* K; bf16_t* V; const float* costab; const float* sintab; float qscale;
    __device__ __forceinline__ void operator()(const f32x4 (&acc)[2][2][4][2], const Unit& u, int wr, int wc, int fr, int fq) const {
        const int which = u.pn >> 2, colt = (u.pn & 3) * BM + wc * 32 + 4 * fq;
        const bool isctx = u.pm >= 128; const int b = isctx ? (u.pm - 128) : (u.pm >> 5), t0 = isctx ? 0 : (u.pm & 31) * BM;
        const size_t tokrow0 = (size_t)u.pm * BM, kvrow0 = (size_t)b * KVR + (isctx ? T_ : t0);
        bf16_t* base = which == 0 ? Q + tokrow0 * 1024 : (which == 1 ? K : V) + kvrow0 * 1024;
        const float sc = which == 0 ? qscale : 1.0f; const bool rope = (which < 2) && !isctx;
#pragma unroll
        for (int ai = 0; ai < 2; ++ai)
#pragma unroll
            for (int m = 0; m < 4; ++m) { const int rowt = ai * HALF + wr * 64 + m * 16 + fr;
                f32x4 cs = (f32x4){1.f, 1.f, 1.f, 1.f}, sn = (f32x4){0.f, 0.f, 0.f, 0.f};
                if (rope) { const int t = t0 + rowt, pos = (wc & 1) ? (t & 63) : (t >> 6); cs = *(const f32x4*)(costab + pos * 16 + 4 * fq); sn = *(const f32x4*)(sintab + pos * 16 + 4 * fq); }
#pragma unroll
                for (int bj = 0; bj < 2; ++bj) { const f32x4 x1 = acc[ai][bj][m][0], x2 = acc[ai][bj][m][1];
                    const f32x4 o1 = (x1 * cs - x2 * sn) * sc, o2 = (x2 * cs + x1 * sn) * sc;
                    u32x2 w1, w2; w1.x = cvt_pk_bf16(o1[0], o1[1]); w1.y = cvt_pk_bf16(o1[2], o1[3]); w2.x = cvt_pk_bf16(o2[0], o2[1]); w2.y = cvt_pk_bf16(o2[2], o2[3]);
                    bf16_t* p = base + (size_t)rowt * 1024 + colt + bj * HALF; *(u32x2*)p = w1; *(u32x2*)(p + 16) = w2; } }
    }
};

struct EpiPlain {
    static constexpr bool PERM = true, AFTER_DRAIN = false;
    bf16_t* O; int ldc; int mode; size_t plane; bf16_t* L1;
    __device__ __forceinline__ void operator()(const f32x4 (&acc)[2][2][4][2], const Unit& u, int wr, int wc, int fr, int fq) const {
        bf16_t* base = O; int ld = ldc, colt = u.pn * BM, act = 0;
        if (mode == 1) { if (u.pn < 12) { base = O + (size_t)(u.pn >> 2) * plane; colt = (u.pn & 3) * BM; ld = 1024; } else { base = L1; colt = (u.pn - 12) * BM; ld = 768; act = u.pn - 11; } }
        const int row0 = u.pm * BM + wr * 64 + fr, col0 = colt + wc * 32 + 8 * fq;
#pragma unroll
        for (int ai = 0; ai < 2; ++ai)
#pragma unroll
            for (int m = 0; m < 4; ++m) { bf16_t* rowp = base + (size_t)(row0 + ai * HALF + m * 16) * ld + col0;
#pragma unroll
                for (int bj = 0; bj < 2; ++bj) { f32x4 v0 = acc[ai][bj][m][0], v1 = acc[ai][bj][m][1];
                    if (act == 1) {
#pragma unroll
                        for (int j = 0; j < 4; ++j) { v0[j] = 2.0f * fast_sigmoid(2.0f * v0[j]) - 1.0f; v1[j] = 2.0f * fast_sigmoid(2.0f * v1[j]) - 1.0f; } }
                    else if (act == 3) {
#pragma unroll
                        for (int j = 0; j < 4; ++j) { v0[j] = fast_sigmoid(v0[j]); v1[j] = fast_sigmoid(v1[j]); } }
                    u32x4 w; w.x = cvt_pk_bf16(v0[0], v0[1]); w.y = cvt_pk_bf16(v0[2], v0[3]); w.z = cvt_pk_bf16(v1[0], v1[1]); w.w = cvt_pk_bf16(v1[2], v1[3]);
                    *(u32x4*)(rowp + bj * HALF) = w; } }
    }
};
struct EpiResAtomic {
    static constexpr bool PERM = false, AFTER_DRAIN = false;
    float* dst_ctx; const float* gate; float gs;
    __device__ __forceinline__ void operator()(const f32x4 (&acc)[2][2][4][2], const Unit& u, int wr, int wc, int fr, int fq) const {
        float* dst = dst_ctx + (size_t)(u.pm - 128) * BM * 1024; const int col0 = u.pn * BM + wc * 32 + 4 * fq;
        f32x4 gv[2][2];
#pragma unroll
        for (int bj = 0; bj < 2; ++bj)
#pragma unroll
            for (int n = 0; n < 2; ++n) gv[bj][n] = *(const f32x4*)(gate + 4 * 9216 + col0 + bj * HALF + n * 16) * gs;
#pragma unroll
        for (int ai = 0; ai < 2; ++ai)
#pragma unroll
            for (int m = 0; m < 4; ++m) { const size_t off = (size_t)(ai * HALF + wr * 64 + m * 16 + fr) * 1024 + col0;
#pragma unroll
                for (int bj = 0; bj < 2; ++bj)
#pragma unroll
                    for (int n = 0; n < 2; ++n) { const f32x4 v = gv[bj][n] * acc[ai][bj][m][n]; float* p = dst + off + bj * HALF + n * 16;
                        unsafeAtomicAdd(p, v.x); unsafeAtomicAdd(p + 1, v.y); unsafeAtomicAdd(p + 2, v.z); unsafeAtomicAdd(p + 3, v.w); } }
    }
};

template <class Epi, class Sched, bool ALIGN_EPI = false, bool SP2 = false>
__device__ __forceinline__ void gemm_phase(PG8_LAS unsigned char* lds, const Gemm g, const Sched& S, const Epi& E) {
    const int tid = tid_opaque(), wid = __builtin_amdgcn_readfirstlane(tid >> 6), lane = tid & 63, wr = wid >> 2, wc = wid & 3, fr = lane & 15, fq = lane >> 4;
    const int K = g.K, nt = K / BK;
    unsigned voffA[2], voffB[2];
#pragma unroll
    for (int i = 0; i < 2; ++i) { int R, C; stage_rc(tid * 16 + i * 8192, R, C); const int Rb = Epi::PERM ? ((R & ~31) + perm32(R & 31)) : R;
        voffA[i] = (unsigned)(R * g.lda + C) * 2u; voffB[i] = (unsigned)(Rb * g.ldb + C) * 2u; }
    const size_t kstep = (size_t)(BK * 2);
    const size_t hstepA = (size_t)HALF * g.lda * 2, hstepB = (size_t)HALF * g.ldb * 2;
    const size_t tstepA = 2 * hstepA, tstepB = 2 * hstepB;
    const unsigned ldsw = (unsigned)wid * 1024u;
    const int aoff = lds_byte(wr * 64 + fr, fq * 8), boff = lds_byte(wc * 32 + fr, fq * 8);
#define PG8_SA(b, h) (((b) * 2 + (h)) * HTB)
#define PG8_SB(b, h) ((4 + (b) * 2 + (h)) * HTB)
#define PG8_STAGE(bufoff, gbase, voff) do { _Pragma("unroll") for (int _i = 0; _i < 2; ++_i) \
        __builtin_amdgcn_global_load_lds((const unsigned*)((const char*)(gbase) + (voff)[_i]), (PG8_LAS unsigned*)(lds + (bufoff) + ldsw + _i * 8192), 16, 0, 0); } while (0)
#define PG8_LDA(dst, b, h) do { _Pragma("unroll") for (int m = 0; m < 4; ++m) _Pragma("unroll") for (int k = 0; k < 2; ++k) dst[m][k] = *(const PG8_LAS bf16x8*)(lds + PG8_SA(b, h) + aoff + m * 2048 + k * 1024); } while (0)
#define PG8_LDB(dst, b, h) do { _Pragma("unroll") for (int n = 0; n < 2; ++n) _Pragma("unroll") for (int k = 0; k < 2; ++k) dst[n][k] = *(const PG8_LAS bf16x8*)(lds + PG8_SB(b, h) + boff + n * 2048 + k * 1024); } while (0)
#define PG8_MMA(ai, bj, At, Bt) do { __builtin_amdgcn_s_setprio(1); _Pragma("unroll") for (int m = 0; m < 4; ++m) _Pragma("unroll") for (int n = 0; n < 2; ++n) _Pragma("unroll") for (int k = 0; k < 2; ++k) \
        acc[ai][bj][m][n] = __builtin_amdgcn_mfma_f32_16x16x32_bf16(Bt[n][k], At[m][k], acc[ai][bj][m][n], 0, 0, 0); __builtin_amdgcn_s_setprio(0); } while (0)
#define PG8_WAIT_V(n) asm volatile("s_waitcnt vmcnt(" #n ")" ::: "memory")
#define PG8_WAIT_L(n) asm volatile("s_waitcnt lgkmcnt(" #n ")" ::: "memory")
#define PG8_BAR __builtin_amdgcn_s_barrier()
#define PG8_SCHED __builtin_amdgcn_sched_barrier(0)
    Unit cur, nxt; int ui = 0;
    if (!S.next(0, cur)) return;
    f32x4 acc[2][2][4][2];
#pragma unroll
    for (int a = 0; a < 2; ++a)
#pragma unroll
        for (int b = 0; b < 2; ++b)
#pragma unroll
            for (int m = 0; m < 4; ++m)
#pragma unroll
                for (int n = 0; n < 2; ++n) acc[a][b][m][n] = (f32x4){0.f, 0.f, 0.f, 0.f};
    bf16x8 At[4][2], B0[2][2], B1[2][2];
    const char* cA = (const char*)g.A + (size_t)cur.pm * tstepA + cur.koff; const char* cB = (const char*)g.Bt + (size_t)cur.pn * tstepB + cur.koff;
    S.a_ready(cur);
    if constexpr (SP2) {
        PG8_STAGE(PG8_SB(0, 0), cB, voffB); PG8_STAGE(PG8_SB(0, 1), cB + hstepB, voffB); PG8_STAGE(PG8_SA(0, 0), cA, voffA); PG8_STAGE(PG8_SA(0, 1), cA + hstepA, voffA);
        if (wr == 1) PG8_BAR;
        PG8_WAIT_V(2); PG8_BAR;
        PG8_STAGE(PG8_SB(1, 0), cB + kstep, voffB); PG8_STAGE(PG8_SA(1, 0), cA + kstep, voffA); PG8_STAGE(PG8_SB(1, 1), cB + hstepB + kstep, voffB);
        PG8_WAIT_V(6); PG8_BAR;
    } else {
        PG8_STAGE(PG8_SB(0, 0), cB, voffB); PG8_STAGE(PG8_SA(0, 0), cA, voffA); PG8_STAGE(PG8_SB(0, 1), cB + hstepB, voffB); PG8_STAGE(PG8_SA(0, 1), cA + hstepA, voffA);
        if (wr == 1) PG8_BAR;
        PG8_WAIT_V(4); PG8_BAR;
        PG8_STAGE(PG8_SB(1, 0), cB + kstep, voffB); PG8_STAGE(PG8_SA(1, 0), cA + kstep, voffA); PG8_STAGE(PG8_SB(1, 1), cB + hstepB + kstep, voffB);
        PG8_WAIT_V(6); PG8_BAR;
    }
    for (;;) {
        const bool has_next = S.next(ui + 1, nxt);
        const char* nA = has_next ? (const char*)g.A + (size_t)nxt.pm * tstepA + nxt.koff : cA; const char* nB = has_next ? (const char*)g.Bt + (size_t)nxt.pn * tstepB + nxt.koff : cB;
        for (int t = 0; t < nt; t += 2) {
            const bool last = (t == nt - 2);
            const char* a1 = cA + (size_t)(t + 1) * kstep;
            const char* a2 = last ? nA : cA + (size_t)(t + 2) * kstep; const char* b2 = last ? nB : cB + (size_t)(t + 2) * kstep;
            const char* a3 = a2 + kstep; const char* b3 = b2 + kstep;
            if (last && has_next) S.a_ready(nxt);
            if constexpr (SP2) {
            PG8_LDB(B0, 0, 0); PG8_LDB(B1, 0, 1); PG8_SCHED; PG8_LDA(At, 0, 0); PG8_STAGE(PG8_SA(1, 1), a1 + hstepA, voffA);
            PG8_WAIT_V(8); PG8_WAIT_L(0); PG8_BAR; PG8_MMA(0, 0, At, B0); PG8_MMA(0, 1, At, B1); PG8_BAR; PG8_SCHED;
            PG8_LDA(At, 0, 1); PG8_STAGE(PG8_SB(0, 0), b2, voffB); PG8_STAGE(PG8_SB(0, 1), b2 + hstepB, voffB); PG8_STAGE(PG8_SA(0, 0), a2, voffA);
            PG8_WAIT_V(8); PG8_WAIT_L(0); PG8_BAR; PG8_MMA(1, 0, At, B0); PG8_MMA(1, 1, At, B1); PG8_BAR; PG8_SCHED;
            PG8_LDB(B0, 1, 0); PG8_LDB(B1, 1, 1); PG8_SCHED; PG8_LDA(At, 1, 0); PG8_STAGE(PG8_SA(0, 1), a2 + hstepA, voffA);
            PG8_WAIT_V(8); PG8_WAIT_L(0); PG8_BAR; PG8_MMA(0, 0, At, B0); PG8_MMA(0, 1, At, B1); PG8_BAR; PG8_SCHED;
            PG8_LDA(At, 1, 1); PG8_STAGE(PG8_SB(1, 0), b3, voffB); PG8_STAGE(PG8_SB(1, 1), b3 + hstepB, voffB); PG8_STAGE(PG8_SA(1, 0), a3, voffA);
            PG8_WAIT_V(8); PG8_WAIT_L(0); PG8_BAR; PG8_MMA(1, 0, At, B0); PG8_MMA(1, 1, At, B1); PG8_BAR; PG8_SCHED;
            } else {
            PG8_LDB(B0, 0, 0); PG8_SCHED; PG8_LDA(At, 0, 0); PG8_STAGE(PG8_SA(1, 1), a1 + hstepA, voffA);
            PG8_WAIT_L(8); PG8_BAR; PG8_WAIT_L(0); PG8_MMA(0, 0, At, B0); PG8_BAR; PG8_SCHED;
            PG8_LDB(B1, 0, 1); PG8_STAGE(PG8_SB(0, 0), b2, voffB);
            PG8_BAR; PG8_WAIT_L(0); PG8_MMA(0, 1, At, B1); PG8_BAR;
            PG8_LDA(At, 0, 1); PG8_STAGE(PG8_SA(0, 0), a2, voffA);
            PG8_BAR; PG8_WAIT_L(0); PG8_MMA(1, 0, At, B0); PG8_BAR; PG8_SCHED;
            PG8_STAGE(PG8_SB(0, 1), b2 + hstepB, voffB);
            PG8_WAIT_V(6); PG8_BAR; PG8_MMA(1, 1, At, B1); PG8_BAR;
            PG8_LDB(B0, 1, 0); PG8_SCHED; PG8_LDA(At, 1, 0); PG8_STAGE(PG8_SA(0, 1), a2 + hstepA, voffA);
            PG8_WAIT_L(8); PG8_BAR; PG8_WAIT_L(0); PG8_MMA(0, 0, At, B0); PG8_BAR; PG8_SCHED;
            PG8_LDB(B1, 1, 1); PG8_STAGE(PG8_SB(1, 0), b3, voffB);
            PG8_BAR; PG8_WAIT_L(0); PG8_MMA(0, 1, At, B1); PG8_BAR;
            PG8_LDA(At, 1, 1); PG8_STAGE(PG8_SA(1, 0), a3, voffA);
            PG8_BAR; PG8_WAIT_L(0); PG8_MMA(1, 0, At, B0); PG8_BAR; PG8_SCHED;
            PG8_STAGE(PG8_SB(1, 1), b3 + hstepB, voffB);
            PG8_WAIT_V(6); PG8_BAR; PG8_MMA(1, 1, At, B1); PG8_BAR;
            }
        }
        if constexpr (ALIGN_EPI) { if (wr == 0) PG8_BAR; }
        if constexpr (!Epi::AFTER_DRAIN) { E(acc, cur, wr, wc, fr, fq); S.done(cur); }
        if (!has_next) break;
#pragma unroll
        for (int a = 0; a < 2; ++a)
#pragma unroll
            for (int b = 0; b < 2; ++b)
#pragma unroll
                for (int m = 0; m < 4; ++m)
#pragma unroll
                    for (int n = 0; n < 2; ++n) acc[a][b][m][n] = (f32x4){0.f, 0.f, 0.f, 0.f};
        cur = nxt; cA = nA; cB = nB; ++ui;
        if constexpr (ALIGN_EPI) { if (wr == 1) PG8_BAR; }
    }
    PG8_WAIT_V(0);
    if constexpr (!ALIGN_EPI) { if (wr == 0) PG8_BAR; }
    PG8_BAR;
    if constexpr (Epi::AFTER_DRAIN) { E.fused(acc, cur, wr, wc, fr, fq, lds, wid, lane); S.done(cur); }
#undef PG8_SA
#undef PG8_SB
#undef PG8_STAGE
#undef PG8_LDA
#undef PG8_LDB
#undef PG8_MMA
#undef PG8_WAIT_V
#undef PG8_WAIT_L
#undef PG8_BAR
#undef PG8_SCHED
}
}
namespace attn2 {
using bf16 = unsigned short;
using bf16x8 = __attribute__((ext_vector_type(8))) short;
using s16x4  = __attribute__((ext_vector_type(4))) short;
using f32x16 = __attribute__((ext_vector_type(16))) float;
using u32x4  = __attribute__((ext_vector_type(4))) unsigned;
constexpr int NW = 8, QBLK = 32, KVBLK = 64, LD = 1024, LDO = 2048;
constexpr float SCALE = 0.125f, THR = 8.f;
constexpr size_t SHM_V = KVBLK * 128 * 2, SHM_K = KVBLK * 64 * 2, SHM_ATTN = 2 * SHM_V + 2 * SHM_K + NW * 64 * 4;
#define KSWZ(row, colB) ((row) * 128 + ((colB) ^ (((row) & 7) << 4)))
#define SBAR() __builtin_amdgcn_sched_barrier(0)
__device__ __forceinline__ int crow(int r, int hi) { return (r & 3) + 8 * (r >> 2) + 4 * hi; }
typedef float f32x2_a __attribute__((ext_vector_type(2))); typedef __bf16 bf16x2_a __attribute__((ext_vector_type(2)));
__device__ __forceinline__ unsigned cvtpk(float lo, float hi) { f32x2_a v = {lo, hi}; bf16x2_a b = __builtin_convertvector(v, bf16x2_a); return __builtin_bit_cast(unsigned, b); }
constexpr float THRL = THR * 1.4426950408889634f;
__device__ __forceinline__ void partialSM(f32x16& p0, f32x16& p1, float& mhat, float& alpha, bool first) {
  float pmax = p0[0]; for (int r = 1; r < 16; ++r) pmax = fmaxf(pmax, p0[r]); for (int r = 0; r < 16; ++r) pmax = fmaxf(pmax, p1[r]);
  { auto rr = __builtin_amdgcn_permlane32_swap(__float_as_uint(pmax), __float_as_uint(pmax), false, false);
    pmax = fmaxf(__uint_as_float(rr[0]), __uint_as_float(rr[1])); }
  if (__builtin_expect(!first && __all(pmax <= THRL), 1)) { alpha = 1.f; }
  else { const float dl = first ? pmax : fmaxf(pmax, 0.f); mhat += dl; alpha = first ? 1.f : __builtin_amdgcn_exp2f(-dl);
    for (int r = 0; r < 16; ++r) { p0[r] -= dl; p1[r] -= dl; } }
  for (int r = 0; r < 16; ++r) p0[r] = __builtin_amdgcn_exp2f(p0[r]);
}
__device__ __forceinline__ void finishSM(f32x16& p0, f32x16& p1, float alpha, float& l_reg, bf16x8& pa0, bf16x8& pa1, bf16x8& pa2, bf16x8& pa3) {
  for (int r = 0; r < 16; ++r) p1[r] = __builtin_amdgcn_exp2f(p1[r]);
  float ps = 0; for (int r = 0; r < 16; ++r) ps += p0[r]; for (int r = 0; r < 16; ++r) ps += p1[r];
  { auto rr = __builtin_amdgcn_permlane32_swap(__float_as_uint(ps), __float_as_uint(ps), false, false);
    ps = __uint_as_float(rr[0]) + __uint_as_float(rr[1]); }
  l_reg = l_reg * alpha + ps;
#define PK4(P, BASE, OUT) do { unsigned a0 = cvtpk(P[BASE + 0], P[BASE + 1]), a1 = cvtpk(P[BASE + 2], P[BASE + 3]);   \
    unsigned b0 = cvtpk(P[BASE + 4], P[BASE + 5]), b1 = cvtpk(P[BASE + 6], P[BASE + 7]);                              \
    auto r0 = __builtin_amdgcn_permlane32_swap(a0, b0, false, false); auto r1 = __builtin_amdgcn_permlane32_swap(a1, b1, false, false); \
    u32x4 w = {r0[0], r1[0], r0[1], r1[1]}; OUT = *reinterpret_cast<bf16x8*>(&w); } while (0)
  PK4(p0, 0, pa0); PK4(p0, 8, pa1); PK4(p1, 0, pa2); PK4(p1, 8, pa3);
#undef PK4
}
__device__ __forceinline__ void qkt(f32x16& p0, f32x16& p1, const bf16* Ks, const bf16x8* qr, const float mhat, int r32, int hi) {
  f32x16 negm; for (int r = 0; r < 16; ++r) negm[r] = -mhat;
#pragma unroll
  for (int d0 = 0; d0 < 4; ++d0) { int cb = (d0 * 16 + hi * 8) * 2;
    bf16x8 b0 = *reinterpret_cast<const bf16x8*>((const char*)Ks + KSWZ(r32, cb));
    bf16x8 b1 = *reinterpret_cast<const bf16x8*>((const char*)Ks + KSWZ(32 + r32, cb));
    if (d0 == 0) { p0 = __builtin_amdgcn_mfma_f32_32x32x16_bf16(b0, qr[0], negm, 0, 0, 0); p1 = __builtin_amdgcn_mfma_f32_32x32x16_bf16(b1, qr[0], negm, 0, 0, 0); }
    else { p0 = __builtin_amdgcn_mfma_f32_32x32x16_bf16(b0, qr[d0], p0, 0, 0, 0); p1 = __builtin_amdgcn_mfma_f32_32x32x16_bf16(b1, qr[d0], p1, 0, 0, 0); } }
}
__device__ __forceinline__ int v_st(int k, int c) { const int kk = (k & ~0xC) | ((k & 4) << 1) | ((k & 8) >> 1); return ((kk >> 3) * 4 + (c >> 5)) * 512 + ((kk & 7) * 32 + (c & 31)) * 2; }
__device__ __forceinline__ int v_rd_base(int lane) { return ((lane & 3) << 3) | (((lane >> 2) & 3) << 6) | (((lane >> 4) & 1) << 5) | (((lane >> 5) & 1) << 8); }
constexpr int v_rd_off(int d0, int ks, int half) { return d0 * 512 + ks * 4096 + half * 2048; }
template <int OFF> __device__ __forceinline__ s16x4 tr_read(int vb) { s16x4 r; asm volatile("ds_read_b64_tr_b16 %0, %1 offset:%2" : "=&v"(r) : "v"(vb), "i"(OFF) : "memory"); return r; }
template <int D0> __device__ __forceinline__ void pv_one(f32x16& od, int vb, bf16x8 pa0, bf16x8 pa1, bf16x8 pa2, bf16x8 pa3) {
  const s16x4 l0 = tr_read<v_rd_off(D0, 0, 0)>(vb), h0 = tr_read<v_rd_off(D0, 0, 1)>(vb), l1 = tr_read<v_rd_off(D0, 1, 0)>(vb), h1 = tr_read<v_rd_off(D0, 1, 1)>(vb);
  const s16x4 l2 = tr_read<v_rd_off(D0, 2, 0)>(vb), h2 = tr_read<v_rd_off(D0, 2, 1)>(vb), l3 = tr_read<v_rd_off(D0, 3, 0)>(vb), h3 = tr_read<v_rd_off(D0, 3, 1)>(vb);
  asm volatile("s_waitcnt lgkmcnt(0)" ::: "memory"); SBAR();
#define PK(L, H) (bf16x8){L[0], L[1], L[2], L[3], H[0], H[1], H[2], H[3]}
  od = __builtin_amdgcn_mfma_f32_32x32x16_bf16(pa0, PK(l0, h0), od, 0, 0, 0);
  od = __builtin_amdgcn_mfma_f32_32x32x16_bf16(pa1, PK(l1, h1), od, 0, 0, 0);
  od = __builtin_amdgcn_mfma_f32_32x32x16_bf16(pa2, PK(l2, h2), od, 0, 0, 0);
  od = __builtin_amdgcn_mfma_f32_32x32x16_bf16(pa3, PK(l3, h3), od, 0, 0, 0);
#undef PK
}
__device__ __forceinline__ void pv_d0(f32x16* o, int vb, bf16x8 pa0, bf16x8 pa1, bf16x8 pa2, bf16x8 pa3) {
  pv_one<0>(o[0], vb, pa0, pa1, pa2, pa3); pv_one<1>(o[1], vb, pa0, pa1, pa2, pa3); pv_one<2>(o[2], vb, pa0, pa1, pa2, pa3); pv_one<3>(o[3], vb, pa0, pa1, pa2, pa3);
}
__device__ __forceinline__ void attn_dense_body(const bf16* __restrict__ Qb, const bf16* __restrict__ Kh, const bf16* __restrict__ Vh, bf16* __restrict__ Ob, int seq, char* lds) {
  const int tid = tid_opaque(), wid = tid >> 6, lane = tid & 63, r32 = lane & 31, hi = lane >> 5;
  bf16* V_lds = (bf16*)lds; bf16* K_lds = (bf16*)(lds + 2 * SHM_V);
  float* ws = (float*)(lds + 2 * SHM_V + 2 * SHM_K) + wid * 64; float* li_l = ws; float* al_l = ws + 32;
  float m_reg = 0.f, l_reg = 0; f32x16 o[4] = {}; bf16x8 qr[4];
  const bf16* Qw = Qb + (long)(wid * QBLK + r32) * LD + hi * 8;
#pragma unroll
  for (int d0 = 0; d0 < 4; ++d0) qr[d0] = *reinterpret_cast<const bf16x8*>(Qw + d0 * 16);
  const int sr = tid >> 4, sc = (tid & 15) * 8, vst0 = v_st(sr, sc), vst1 = v_st(32 + sr, sc);
  const int kr = tid >> 3, kc = (tid & 7) * 8, kst = KSWZ(kr, kc * 2);
  const int vb0 = (int)(uintptr_t)V_lds + v_rd_base(lane);
  struct { bf16x8 vs0, vs1, ks0; } sr_[2];
#define SLOAD(i, k0) do { sr_[i].vs0 = *reinterpret_cast<const bf16x8*>(&Vh[(long)((k0) + sr) * LD + sc]); sr_[i].vs1 = *reinterpret_cast<const bf16x8*>(&Vh[(long)((k0) + 32 + sr) * LD + sc]); \
    sr_[i].ks0 = *reinterpret_cast<const bf16x8*>(&Kh[(long)((k0) + kr) * LD + kc]); } while (0)
#define SWRITE(b, i) do { *(bf16x8*)((char*)V_lds + (b) * SHM_V + vst0) = sr_[i].vs0; *(bf16x8*)((char*)V_lds + (b) * SHM_V + vst1) = sr_[i].vs1; \
    *(bf16x8*)((char*)K_lds + (b) * SHM_K + kst) = sr_[i].ks0; } while (0)
#define SWAIT() asm volatile("s_waitcnt vmcnt(3)" ::: "memory")
#define RESC(a) do { if (__any((a) < 1.f)) { if (hi == 0) al_l[r32] = (a); asm volatile("s_waitcnt lgkmcnt(0)" ::: "memory"); \
    for (int d = 0; d < 4; ++d) for (int r = 0; r < 16; ++r) o[d][r] *= al_l[crow(r, hi)]; } } while (0)
  f32x16 pA0, pA1, pB0, pB1; float alA, alB; bf16x8 pa0, pa1, pa2, pa3; const int NT = seq / KVBLK;
  constexpr int SE = 0, SO = 1;
  SLOAD(SE, 0); asm volatile("s_waitcnt vmcnt(0)" ::: "memory"); SWRITE(0, SE); __syncthreads();
  qkt(pA0, pA1, K_lds, qr, m_reg, r32, hi); partialSM(pA0, pA1, m_reg, alA, true);
  SLOAD(SO, KVBLK); if (2 < NT) SLOAD(SE, 2 * KVBLK);
  if (2 < NT) SWAIT(); else asm volatile("s_waitcnt vmcnt(0)" ::: "memory");
  SWRITE(1, SO); __syncthreads();
  for (int j = 1; j + 1 < NT; j += 2) {
    SBAR(); qkt(pB0, pB1, (bf16*)((char*)K_lds + SHM_K), qr, m_reg, r32, hi);
    finishSM(pA0, pA1, alA, l_reg, pa0, pa1, pa2, pa3); SBAR();
    SLOAD(SO, (j + 2) * KVBLK); SBAR();
    pv_d0(o, vb0, pa0, pa1, pa2, pa3); partialSM(pB0, pB1, m_reg, alB, false);
    __syncthreads(); SWAIT(); SWRITE(0, SE);
    RESC(alB); __syncthreads();
    SBAR(); qkt(pA0, pA1, K_lds, qr, m_reg, r32, hi);
    finishSM(pB0, pB1, alB, l_reg, pa0, pa1, pa2, pa3); SBAR();
    if (j + 3 < NT) SLOAD(SE, (j + 3) * KVBLK); SBAR();
    pv_d0(o, vb0 + (int)SHM_V, pa0, pa1, pa2, pa3); partialSM(pA0, pA1, m_reg, alA, false);
    __syncthreads(); if (j + 3 < NT) SWAIT(); else asm volatile("s_waitcnt vmcnt(0)" ::: "memory"); SWRITE(1, SO);
    RESC(alA); __syncthreads();
  }
  SBAR(); qkt(pB0, pB1, (bf16*)((char*)K_lds + SHM_K), qr, m_reg, r32, hi);
  finishSM(pA0, pA1, alA, l_reg, pa0, pa1, pa2, pa3); SBAR();
  pv_d0(o, vb0, pa0, pa1, pa2, pa3); partialSM(pB0, pB1, m_reg, alB, false);
  __syncthreads(); RESC(alB);
  finishSM(pB0, pB1, alB, l_reg, pa0, pa1, pa2, pa3); SBAR();
  pv_d0(o, vb0 + (int)SHM_V, pa0, pa1, pa2, pa3);
  if (hi == 0) li_l[r32] = l_reg; asm volatile("s_waitcnt lgkmcnt(0)" ::: "memory");
  float rli[16];
#pragma unroll
  for (int r = 0; r < 16; ++r) rli[r] = __builtin_amdgcn_rcpf(li_l[crow(r, hi)]);
  bf16* Ow = Ob + (long)(wid * QBLK) * LDO;
#pragma unroll
  for (int r = 0; r < 16; ++r) { const int orow = crow(r, hi);
#pragma unroll
    for (int d0 = 0; d0 < 4; d0 += 1) { const unsigned w = cvtpk(o[d0][r] * rli[r], 0.f); Ow[(long)orow * LDO + d0 * 32 + r32] = (bf16)(w & 0xffffu); } }
#undef SLOAD
#undef SWRITE
#undef SWAIT
#undef RESC
}
#undef KSWZ
#undef SBAR
}
constexpr size_t MiB = 1u << 20;
constexpr size_t WS_MOD = 0;
constexpr size_t WS_COS = 512 * 1024, WS_SIN = WS_COS + 8192;
constexpr size_t WS_BON = 1 * MiB;
constexpr size_t WS_HCTX = 8 * MiB;
constexpr size_t WS_W13A = 12 * MiB, WS_W2A = 23 * MiB, WS_W13B = 29 * MiB, WS_W2B = 40 * MiB, WS_WMIX = 46 * MiB, WS_G2T = 61 * MiB, WS_WO = 62 * MiB;
constexpr size_t WS_ARENA = 64 * MiB;
constexpr size_t WS_U = WS_ARENA;
constexpr size_t WS_ACT = WS_ARENA + 66 * MiB;
constexpr size_t WS_Q = WS_ARENA + 66 * MiB, WS_K = WS_Q + 66 * MiB, WS_V = WS_K + 66 * MiB, WS_O1 = WS_V + 66 * MiB;
constexpr size_t WS_A2 = WS_ARENA;
constexpr size_t WS_RKV = WS_ARENA + 132 * MiB;
constexpr size_t WS_L1 = WS_RKV + 198 * MiB;
constexpr size_t WS_GG = WS_ARENA;
constexpr size_t WS_Y0 = WS_ARENA + 66 * MiB;
constexpr size_t WS_Y1 = WS_L1 + 50 * MiB;
constexpr size_t WS_FO = WS_RKV;
constexpr size_t WS_END = 512 * MiB;
static_assert(WS_O1 + 132 * MiB <= WS_END && WS_Y1 + 66 * MiB <= WS_END && WS_ACT + 182 * MiB <= WS_END, "ws map");
constexpr size_t PLANE = (size_t)MTOK * 1024;

constexpr int RING_BYTES = 131072, LDS_BYTES = 147456;

typedef unsigned short bf16;
typedef unsigned v4u __attribute__((ext_vector_type(4)));
typedef unsigned v2u __attribute__((ext_vector_type(2)));
typedef float f32x4 __attribute__((ext_vector_type(4)));
typedef float f32x16 __attribute__((ext_vector_type(16)));
typedef short bf16x8 __attribute__((ext_vector_type(8)));
#define LAS __attribute__((address_space(3)))
__device__ __forceinline__ unsigned f2bf(float f) { unsigned u = __builtin_bit_cast(unsigned, f); return (u + 0x7fffu + ((u >> 16) & 1u)) >> 16; }
__device__ __forceinline__ unsigned pk2(float lo, float hi) { return pg8::cvt_pk_bf16(lo, hi); }
__device__ __forceinline__ float bflo(unsigned w) { return __builtin_bit_cast(float, w << 16); }
__device__ __forceinline__ float bfhi(unsigned w) { return __builtin_bit_cast(float, w & 0xffff0000u); }
__device__ __forceinline__ float wave_sum(float v) {
#pragma unroll
    for (int o = 1; o < 64; o <<= 1) v += __shfl_xor(v, o);
    return v;
}
__device__ __forceinline__ float sigm(float x) { return 1.0f / (1.0f + __expf(-x)); }
__device__ __forceinline__ float sigf(float x) { return __builtin_amdgcn_rcpf(1.0f + __expf(-x)); }

constexpr size_t WS_XBAR = 768 * 1024;
constexpr int LDS_XB = RING_BYTES + 256;
#define XB_TMO      128
#define XB_XCNT(j)  (256  + 64 * (j))
#define XB_XSUB(j)  (1280 + 64 * (j))
#define XB_XGEN(j)  (2304 + 64 * (j))
#define XB_TOP      3328
#define XB_TOPGEN   3392
#define XCD_BAR_WORDS 3456
#define XB_SPIN_CAP (1u << 18)

__device__ __forceinline__ unsigned xb_ld(unsigned* p)              { return __hip_atomic_load(p, __ATOMIC_RELAXED, __HIP_MEMORY_SCOPE_AGENT); }
__device__ __forceinline__ unsigned xb_add(unsigned* p, unsigned v) { return __hip_atomic_fetch_add(p, v, __ATOMIC_RELAXED, __HIP_MEMORY_SCOPE_AGENT); }
__device__ __forceinline__ unsigned xb_xcc_id() { return (unsigned)__builtin_amdgcn_s_getreg((3 << 11) | 20) & 0xFu; }
#define XB_SPIN(cond, bar) do { unsigned _sp = 0; while (cond) { __builtin_amdgcn_s_sleep(1); \
    if ((++_sp & 255u) == 0u) { if (xb_ld(&(bar)[XB_TMO])) break; if (_sp > XB_SPIN_CAP) { atomicAdd(&(bar)[XB_TMO], 1u); break; } } } } while (0)

struct XcdBarrier {
    unsigned* bar; unsigned x;
    volatile LAS unsigned* st;
};

__device__ __forceinline__ XcdBarrier xcd_barrier_post(unsigned* bar, volatile LAS unsigned* st) {
    XcdBarrier b; b.bar = bar; b.x = xb_xcc_id(); b.st = st;
    if (threadIdx.x == 0) (void)xb_add(&bar[XB_XCNT(b.x)], 1u);
    return b;
}
__device__ __forceinline__ void xcd_barrier_complete(unsigned* bar, unsigned x, unsigned& nloc, unsigned& nx) {
    const unsigned G = gridDim.x * gridDim.y * gridDim.z;
    unsigned sum, cnt, mine, sp = 0u;
    for (;;) {
        sum = 0u; cnt = 0u; mine = 0u;
#pragma unroll
        for (unsigned j = 0; j < 16; ++j) { const unsigned c = xb_ld(&bar[XB_XCNT(j)]); sum += c; cnt += (c > 0u) ? 1u : 0u; mine = (j == x) ? c : mine; }
        if (sum == G) break;
        __builtin_amdgcn_s_sleep(1);
        if ((++sp & 255u) == 0u) { if (xb_ld(&bar[XB_TMO])) break; if (sp > XB_SPIN_CAP) { atomicAdd(&bar[XB_TMO], 1u); break; } }
    }
    nloc = mine > 0u ? mine : 1u; nx = cnt > 0u ? cnt : 1u;
}

__device__ __forceinline__ void xcd_barrier(const XcdBarrier& b) {
    asm volatile("s_waitcnt vmcnt(0)" ::: "memory");
    __syncthreads();
    if (threadIdx.x == 0) {
        unsigned* bar = b.bar;
        __builtin_amdgcn_s_waitcnt(0);
        unsigned nloc = b.st[0], nx = b.st[1];
        if (nloc == 0u) { xcd_barrier_complete(bar, b.x, nloc, nx); b.st[0] = nloc; b.st[1] = nx; }
        const unsigned old = xb_add(&bar[XB_XSUB(b.x)], 1u);
        const unsigned gen = old / nloc;
        if (old + 1u == (gen + 1u) * nloc) {
            __builtin_amdgcn_fence(__ATOMIC_RELEASE, "agent");
            asm volatile("s_waitcnt vmcnt(0)" ::: "memory");
            const unsigned og = xb_add(&bar[XB_TOP], 1u);
            const unsigned tg = og / nx;
            if (og + 1u == (tg + 1u) * nx) xb_add(&bar[XB_TOPGEN], 1u);
            else XB_SPIN(xb_ld(&bar[XB_TOPGEN]) == tg, bar);
            __builtin_amdgcn_fence(__ATOMIC_ACQUIRE, "agent");
            xb_add(&bar[XB_XGEN(b.x)], 1u);
            asm volatile("s_waitcnt vmcnt(0)" ::: "memory");
        } else {
            XB_SPIN(xb_ld(&bar[XB_XGEN(b.x)]) == gen, bar);
            __builtin_amdgcn_fence(__ATOMIC_ACQUIRE, "agent");
            asm volatile("s_waitcnt vmcnt(0)" ::: "memory");
        }
    }
    __syncthreads();
}

struct Args {
    const float* in[30]; float* out; unsigned char* ws; int ph_lo, ph_hi;
};
typedef const __attribute__((address_space(4))) Args* KArgs;
__device__ __forceinline__ KArgs kargs() { KArgs p = (KArgs)__builtin_amdgcn_kernarg_segment_ptr(); asm volatile("" : "+s"(p)); return p; }
struct Ctx {
    int wave, G, bx, gw, NGW;
    LAS unsigned char* lds; unsigned char* ws; bf16* hlat; float* hctx; const float* mod;
};
#define TID tid_
#define LANE lane_
#define TID_INIT const int tid_ = tid_opaque(); const int lane_ = tid_ & 63; (void)lane_;

__device__ __forceinline__ void transpose_item(const float* W, int ldw, int k0, int n0, bf16* WT, int ldt, int drow0, int dk0, const float* kscale, LAS float* scr, int lane) {
#pragma unroll 8
    for (int i = 0; i < 32; ++i) { const int kk = 2 * i + (lane >> 5); float v = W[(size_t)(k0 + kk) * ldw + n0 + (lane & 31)]; if (kscale) v *= kscale[k0 + kk]; scr[kk * 33 + (lane & 31)] = v; }
    asm volatile("s_waitcnt lgkmcnt(0)" ::: "memory");
    const int c = lane & 7;
#pragma unroll
    for (int j = 0; j < 4; ++j) { const int n = (lane >> 3) + 8 * j; const LAS float* s = scr + (8 * c) * 33 + n;
        v4u o; o.x = pk2(s[0 * 33], s[1 * 33]); o.y = pk2(s[2 * 33], s[3 * 33]); o.z = pk2(s[4 * 33], s[5 * 33]); o.w = pk2(s[6 * 33], s[7 * 33]);
        *(v4u*)(WT + (size_t)(drow0 + n) * ldt + dk0 + k0 + 8 * c) = o; }
    asm volatile("s_waitcnt lgkmcnt(0)" ::: "memory");
}
__device__ __forceinline__ bool conv_job(int& it, const float* W, int K, int N, bf16* WT, int ldt, int row_off, int dk0, const float* kscale, int mapping, LAS float* scr, int lane) {
    const int nblk = N / 32, nit = (K / 64) * nblk;
    if (it >= nit) { it -= nit; return false; }
    const int kb = it / nblk, nb = it % nblk, n0 = nb * 32;
    int drow0 = row_off + n0;
    if (mapping == 1) { const int bj = n0 >= FF_ ? 1 : 0, hid = n0 - bj * FF_; drow0 = 256 * (hid >> 7) + 128 * bj + (hid & 127); }
    transpose_item(W, N, kb * 64, n0, WT, ldt, drow0, dk0, kscale, scr, lane);
    return true;
}
__device__ __forceinline__ void convert_layer_weights(KArgs a, const Ctx& C, int l) {
    TID_INIT
    LAS float* scr = (LAS float*)(C.lds + C.wave * 16384);
    bf16* w13a = (bf16*)(C.ws + WS_W13A); bf16* w2a = (bf16*)(C.ws + WS_W2A); bf16* w13b = (bf16*)(C.ws + WS_W13B); bf16* w2b = (bf16*)(C.ws + WS_W2B);
    bf16* wmix = (bf16*)(C.ws + WS_WMIX); bf16* wo = (bf16*)(C.ws + WS_WO); bf16* g2t = (bf16*)(C.ws + WS_G2T);
    const float* f13 = a->in[7] + (size_t)l * 2 * 1024 * 5632; const float* f2 = a->in[8] + (size_t)l * 2 * FF_ * 1024;
    const int NIT = 2 * (16 * 176 + 44 * 32) + (l == 0 ? (16 * 96 + 16 * 32) : (6 * 16 * 32 + 8 * 16 * 2 + 2 * 16 * 5 + 16 * 32));
    for (int it0 = C.gw; it0 < NIT; it0 += C.NGW) {
        int it = it0;
        if (conv_job(it, f13, 1024, 5632, w13a, 1024, 0, 0, nullptr, 1, scr, LANE)) continue;
        if (conv_job(it, f2, FF_, 1024, w2a, FF_, 0, 0, nullptr, 0, scr, LANE)) continue;
        if (conv_job(it, f13 + (size_t)1024 * 5632, 1024, 5632, w13b, 1024, 0, 0, nullptr, 1, scr, LANE)) continue;
        if (conv_job(it, f2 + (size_t)FF_ * 1024, FF_, 1024, w2b, FF_, 0, 0, nullptr, 0, scr, LANE)) continue;
        if (l == 0) {
            if (conv_job(it, a->in[9], 1024, 3072, wmix, 1024, 0, 0, nullptr, 0, scr, LANE)) continue;
            conv_job(it, a->in[10], 1024, 1024, wo, 1024, 0, 0, nullptr, 0, scr, LANE);
        } else {
            const float* mix = a->in[13]; bool done = false;
            for (int p = 0; p < 3 && !done; ++p) {
                if (conv_job(it, a->in[14] + (size_t)p * 1024 * 1024, 1024, 1024, wmix, 2048, p * 1024, 0, nullptr, 0, scr, LANE)) { done = true; break; }
                if (conv_job(it, a->in[14] + (size_t)p * 1024 * 1024, 1024, 1024, wmix, 2048, p * 1024, 1024, mix + p * 1024, 0, scr, LANE)) { done = true; break; }
            }
            if (done) continue;
            for (int z = 0; z < 2 && !done; ++z) {
                if (conv_job(it, a->in[16] + (size_t)z * 1024 * 64, 1024, 64, wmix, 2048, 3072 + 64 * z, 0, nullptr, 0, scr, LANE)) { done = true; break; }
                if (conv_job(it, a->in[16] + (size_t)z * 1024 * 64, 1024, 64, wmix, 2048, 3072 + 64 * z, 1024, mix + 3 * 1024, 0, scr, LANE)) { done = true; break; }
                if (conv_job(it, a->in[19] + (size_t)z * 1024 * 64, 1024, 64, wmix, 2048, 3328 + 64 * z, 0, nullptr, 0, scr, LANE)) { done = true; break; }
                if (conv_job(it, a->in[19] + (size_t)z * 1024 * 64, 1024, 64, wmix, 2048, 3328 + 64 * z, 1024, mix + 4 * 1024, 0, scr, LANE)) { done = true; break; }
            }
            if (done) continue;
            if (conv_job(it, a->in[21], 1024, 160, wmix, 2048, 3584, 0, nullptr, 0, scr, LANE)) continue;
            if (conv_job(it, a->in[21], 1024, 160, wmix, 2048, 3584, 1024, mix + 5 * 1024, 0, scr, LANE)) continue;
            conv_job(it, a->in[28], 1024, 1024, wo, 1024, 0, 0, nullptr, 0, scr, LANE);
        }
    }
    if (l == 1) {
        const int gt = C.gw * 64 + LANE, NT = C.NGW * 64;
        unsigned zz = 0u; asm volatile("" : "+v"(zz)); const v4u zero4 = (v4u){zz, zz, zz, zz};
        for (int i = gt; i < 352 * 256; i += NT) { const int r = i >> 8, ch = i & 255; const int row = r < 128 ? 3200 + r : (r < 256 ? 3456 + (r - 128) : 3744 + (r - 256));
            *(v4u*)(wmix + (size_t)row * 2048 + ch * 8) = zero4; }
        const float* g2 = a->in[22];
        for (int i = gt; i < 1024 * 32; i += NT) { const int ch = i >> 10, n = i & 1023; float v[8];
#pragma unroll
            for (int j = 0; j < 8; ++j) { const int k = ch * 8 + j; v[j] = k < 160 ? g2[(size_t)k * 1024 + n] : 0.f; }
            *(v4u*)(g2t + (size_t)n * 256 + ch * 8) = (v4u){pk2(v[0], v[1]), pk2(v[2], v[3]), pk2(v[4], v[5]), pk2(v[6], v[7])}; }
    }
}

__device__ __forceinline__ void adaln_phase(KArgs a, const Ctx& C) {
    TID_INIT
    LAS float* sS = (LAS float*)C.lds;
    LAS float* red = sS + 5 * 1024;
    for (int i = TID; i < 5 * 1024; i += 512) { const float x = i < 4096 ? a->in[1][i] : a->in[3][i - 4096]; sS[i] = x * sigm(x); }
    __syncthreads();
    float* mod = (float*)(C.ws + WS_MOD);
    for (int item = C.bx; item < 288; item += C.G) {
        const int l = item / 144, col = (item % 144) * 64 + LANE;
        const float* W = a->in[4] + (size_t)l * 1024 * 9216 + col;
        float acc[5] = {0.f, 0.f, 0.f, 0.f, 0.f};
        const int kb = 128 * C.wave;
#pragma unroll 8
        for (int k = 0; k < 128; ++k) { const float w = W[(size_t)(kb + k) * 9216];
#pragma unroll
            for (int b = 0; b < 5; ++b) acc[b] += sS[b * 1024 + kb + k] * w; }
#pragma unroll
        for (int b = 0; b < 5; ++b) red[(C.wave * 5 + b) * 64 + LANE] = acc[b];
        __syncthreads();
        if (C.wave < 5) { float s = 0.f;
#pragma unroll
            for (int w = 0; w < 8; ++w) s += red[(w * 5 + C.wave) * 64 + LANE];
            mod[(size_t)(l * 5 + C.wave) * 9216 + col] = s + a->in[5][(size_t)l * 9216 + col]; }
        __syncthreads();
    }
    if (C.bx == C.G - 1) {
        float* ct = (float*)(C.ws + WS_COS); float* st = (float*)(C.ws + WS_SIN);
        for (int i = TID; i < 2048; i += 512) { const int pos = i >> 4, f = i & 15;
            const float inv = exp2f(-(float)f * (1.0f / 16.0f) * 13.287712379549449f);
            const float ang = (float)pos * inv; const double rev = (double)ang * 0.15915494309189535; const float fr = (float)(rev - floor(rev));
            ct[i] = __builtin_amdgcn_cosf(fr); st[i] = __builtin_amdgcn_sinf(fr); }
    }
}

__device__ __forceinline__ void modnorm_phase(const Ctx& C, const float* hl32, const bf16* hlb, const float* hc, int nrows, const float* nw, const float* modl, int ishift, bf16* out, int ldo) {
    TID_INIT
    constexpr int NR = 4;
    for (int row0 = C.gw; row0 < nrows; row0 += NR * C.NGW) {
        f32x4 v[NR][4]; float ss[NR];
#pragma unroll
        for (int q = 0; q < NR; ++q) { const int row = row0 + q * C.NGW; ss[q] = 0.f;
            if (row < nrows) { const bool isctx = row >= MLAT;
                if (isctx || hl32) { const float* hr = isctx ? hc + (size_t)(row - MLAT) * 1024 : hl32 + (size_t)row * 1024;
#pragma unroll
                    for (int j = 0; j < 4; ++j) v[q][j] = *(const f32x4*)(hr + 4 * LANE + 256 * j); }
                else { const bf16* hr = hlb + (size_t)row * 1024;
#pragma unroll
                    for (int j = 0; j < 4; ++j) { const v2u w = *(const v2u*)(hr + 4 * LANE + 256 * j); const fl32x2_t a0 = unpkh(w.x), a1 = unpkh(w.y); v[q][j] = (f32x4){a0.x, a0.y, a1.x, a1.y}; } } }
            else {
#pragma unroll
                for (int j = 0; j < 4; ++j) v[q][j] = (f32x4){0.f, 0.f, 0.f, 0.f}; } }
#pragma unroll
        for (int q = 0; q < NR; ++q) {
#pragma unroll
            for (int j = 0; j < 4; ++j) ss[q] += (v[q][j].x * v[q][j].x + v[q][j].y * v[q][j].y) + (v[q][j].z * v[q][j].z + v[q][j].w * v[q][j].w);
            ss[q] = wave_sum(ss[q]); }
#pragma unroll
        for (int q = 0; q < NR; ++q) { const int row = row0 + q * C.NGW;
            if (row < nrows) { const int bb = row >= MLAT ? 4 : (row >> 13); const float* sh = modl + bb * 9216 + ishift * 1024; const float* sc = sh + 1024;
                const float rstd = 1.0f / sqrtf(ss[q] * (1.0f / 1024.0f) + 1e-6f); bf16* orow = out + (size_t)row * ldo;
#pragma unroll
                for (int j = 0; j < 4; ++j) { const int c = 4 * LANE + 256 * j; const f32x4 w = *(const f32x4*)(nw + c), s1 = *(const f32x4*)(sc + c), s0 = *(const f32x4*)(sh + c);
                    const f32x4 y = (v[q][j] * rstd * w) * (s1 + 1.0f) + s0; *(v2u*)(orow + c) = (v2u){pk2(y.x, y.y), pk2(y.z, y.w)}; } } }
    }
}
__device__ __forceinline__ void shift_phase(const Ctx& C, bf16* A) {
    TID_INIT
    for (int row = C.gw; row < MTOK; row += C.NGW) {
        int t, len; if (row < MLAT) { t = row & (T_ - 1); len = T_; } else { t = (row - MLAT) & (CTX_ - 1); len = CTX_; }
        const bf16* ur = A + (size_t)row * 2048;
#pragma unroll
        for (int j = 0; j < 2; ++j) { const int c = 8 * LANE + 512 * j;
            const v4u u0 = *(const v4u*)(ur + c); v4u up = (v4u){0u, 0u, 0u, 0u}, un = up;
            if (t > 0) up = *(const v4u*)(ur - 2048 + c);
            if (t < len - 1) un = *(const v4u*)(ur + 2048 + c);
            v4u o;
#pragma unroll
            for (int q = 0; q < 4; ++q) { const float lo = 0.5f * (bflo(up[q]) + bflo(un[q])) - bflo(u0[q]), hi = 0.5f * (bfhi(up[q]) + bfhi(un[q])) - bfhi(u0[q]); o[q] = pk2(lo, hi); }
            *(v4u*)((bf16*)ur + 1024 + c) = o; }
    }
}
__device__ __forceinline__ void attn_combine_phase(KArgs a, const Ctx& C, const bf16* O1, bf16* ao) {
    TID_INIT
    const float* lv = a->in[11];
    const float d1 = wave_sum(lv[LANE] * lv[64 + LANE]), d2 = wave_sum(lv[128 + LANE] * lv[192 + LANE]);
    const float lam_init = 0.2f, lam = expf(d1) - expf(d2) + lam_init;
    const int hh = LANE >> 3, sub = LANE & 7;
    float sw[16];
#pragma unroll
    for (int i = 0; i < 16; ++i) sw[i] = a->in[12][16 * sub + i] * (1.0f - lam_init);
    constexpr int NR = 2;
    for (int row0 = C.gw; row0 < MTOK; row0 += NR * C.NGW) {
        v4u a0[NR], a1[NR], b0[NR], b1[NR];
#pragma unroll
        for (int u = 0; u < NR; ++u) { const int row = row0 + u * C.NGW; const bf16* p = O1 + (size_t)(row < MTOK ? row : row0) * 2048 + 256 * hh + 16 * sub;
            a0[u] = *(const v4u*)p; a1[u] = *(const v4u*)(p + 8); b0[u] = *(const v4u*)(p + 128); b1[u] = *(const v4u*)(p + 136); }
#pragma unroll
        for (int u = 0; u < NR; ++u) { const int row = row0 + u * C.NGW;
            float d[16]; float ss = 0.f;
#pragma unroll
            for (int q = 0; q < 4; ++q) { const unsigned wa0 = a0[u][q], wb0 = b0[u][q], wa1 = a1[u][q], wb1 = b1[u][q];
                d[2 * q] = bflo(wa0) - lam * bflo(wb0); d[2 * q + 1] = bfhi(wa0) - lam * bfhi(wb0); d[8 + 2 * q] = bflo(wa1) - lam * bflo(wb1); d[8 + 2 * q + 1] = bfhi(wa1) - lam * bfhi(wb1); }
#pragma unroll
            for (int i = 0; i < 16; ++i) ss += d[i] * d[i];
            ss += __shfl_xor(ss, 1); ss += __shfl_xor(ss, 2); ss += __shfl_xor(ss, 4);
            const float r = 1.0f / sqrtf(ss * (1.0f / 128.0f) + 1e-5f);
            v4u o0, o1;
#pragma unroll
            for (int q = 0; q < 4; ++q) { o0[q] = pk2(d[2 * q] * r * sw[2 * q], d[2 * q + 1] * r * sw[2 * q + 1]); o1[q] = pk2(d[8 + 2 * q] * r * sw[8 + 2 * q], d[8 + 2 * q + 1] * r * sw[8 + 2 * q + 1]); }
            if (row < MTOK) { bf16* op = ao + (size_t)row * 1024 + 128 * hh + 16 * sub; *(v4u*)op = o0; *(v4u*)(op + 8) = o1; } }
    }
}
__device__ __forceinline__ void rwkv_finish_phase(KArgs a, const Ctx& C, int nrows) {
    TID_INIT
    const bf16* y0 = (const bf16*)(C.ws + WS_Y0); const bf16* y1 = (const bf16*)(C.ws + WS_Y1); const bf16* vv = (const bf16*)(C.ws + WS_RKV) + 2 * PLANE; const bf16* gg = (const bf16*)(C.ws + WS_GG);
    const float* bon = (const float*)(C.ws + WS_BON); bf16* fo = (bf16*)(C.ws + WS_FO);
    const int c0 = 16 * LANE, hd = LANE >> 2;
    float lw[16], lb[16];
#pragma unroll
    for (int i = 0; i < 16; ++i) { lw[i] = a->in[26][c0 + i]; lb[i] = a->in[27][c0 + i]; }
    constexpr int NR = 1;
    for (int row0 = C.gw; row0 < nrows; row0 += NR * C.NGW) {
        v4u P[NR][2], Q[NR][2], PV[NR][2], PG[NR][2]; float sbv[NR];
#pragma unroll
        for (int u = 0; u < NR; ++u) { const int row = row0 + u * C.NGW, rr = row < nrows ? row : row0; const size_t o = (size_t)rr * 1024 + c0;
#pragma unroll
            for (int h2 = 0; h2 < 2; ++h2) { P[u][h2] = *(const v4u*)(y0 + o + 8 * h2); Q[u][h2] = *(const v4u*)(y1 + o + 8 * h2); PV[u][h2] = *(const v4u*)(vv + o + 8 * h2); PG[u][h2] = *(const v4u*)(gg + o + 8 * h2); }
            sbv[u] = bon[(size_t)rr * 16 + hd] + bon[(size_t)MTOK * 16 + (size_t)rr * 16 + hd]; }
#pragma unroll
        for (int u = 0; u < NR; ++u) { const int row = row0 + u * C.NGW; const size_t o = (size_t)row * 1024 + c0;
            float y[16], v[16], g[16];
#pragma unroll
            for (int h2 = 0; h2 < 2; ++h2)
#pragma unroll
                for (int k = 0; k < 4; ++k) { const unsigned wp = P[u][h2][k], wq = Q[u][h2][k], wv = PV[u][h2][k], wg = PG[u][h2][k];
                    y[8 * h2 + 2 * k] = bflo(wp) + bflo(wq); y[8 * h2 + 2 * k + 1] = bfhi(wp) + bfhi(wq); v[8 * h2 + 2 * k] = bflo(wv); v[8 * h2 + 2 * k + 1] = bfhi(wv); g[8 * h2 + 2 * k] = bflo(wg); g[8 * h2 + 2 * k + 1] = bfhi(wg); }
            float s = 0.f;
#pragma unroll
            for (int i = 0; i < 16; ++i) s += y[i];
            s += __shfl_xor(s, 1); s += __shfl_xor(s, 2);
            const float mu = s * (1.0f / 64.0f); float q2 = 0.f;
#pragma unroll
            for (int i = 0; i < 16; ++i) { y[i] -= mu; q2 += y[i] * y[i]; }
            q2 += __shfl_xor(q2, 1); q2 += __shfl_xor(q2, 2);
            const float rs = 1.0f / sqrtf(q2 * (1.0f / 64.0f) + 64e-5f), sb = sbv[u];
            v4u o0, o1;
#pragma unroll
            for (int k = 0; k < 4; ++k) {
                const float e0 = (y[2 * k] * rs * lw[2 * k] + lb[2 * k] + sb * v[2 * k]) * g[2 * k], e1 = (y[2 * k + 1] * rs * lw[2 * k + 1] + lb[2 * k + 1] + sb * v[2 * k + 1]) * g[2 * k + 1];
                const float f0 = (y[8 + 2 * k] * rs * lw[8 + 2 * k] + lb[8 + 2 * k] + sb * v[8 + 2 * k]) * g[8 + 2 * k], f1 = (y[9 + 2 * k] * rs * lw[9 + 2 * k] + lb[9 + 2 * k] + sb * v[9 + 2 * k]) * g[9 + 2 * k];
                o0[k] = pk2(e0, e1); o1[k] = pk2(f0, f1); }
            if (row < nrows) { *(v4u*)(fo + o) = o0; *(v4u*)(fo + o + 8) = o1; } }
    }
}
__device__ __forceinline__ void final_norm_phase(KArgs a, const Ctx& C) {
    TID_INIT
    const float* nw = a->in[29]; const bf16* hb = (const bf16*)(C.ws + WS_U); float* out = a->out;
    constexpr int NR = 4;
    for (int row0 = C.gw; row0 < MLAT; row0 += NR * C.NGW) {
        f32x4 v[NR][4]; float ss[NR];
#pragma unroll
        for (int q = 0; q < NR; ++q) { const int row = row0 + q * C.NGW; ss[q] = 0.f; const bf16* hr = hb + (size_t)(row < MLAT ? row : row0) * 1024;
#pragma unroll
            for (int j = 0; j < 4; ++j) { const v2u w = *(const v2u*)(hr + 4 * LANE + 256 * j); const fl32x2_t a0 = unpkh(w.x), a1 = unpkh(w.y); v[q][j] = (f32x4){a0.x, a0.y, a1.x, a1.y}; } }
#pragma unroll
        for (int q = 0; q < NR; ++q) {
#pragma unroll
            for (int j = 0; j < 4; ++j) ss[q] += (v[q][j].x * v[q][j].x + v[q][j].y * v[q][j].y) + (v[q][j].z * v[q][j].z + v[q][j].w * v[q][j].w);
            ss[q] = wave_sum(ss[q]); }
#pragma unroll
        for (int q = 0; q < NR; ++q) { const int row = row0 + q * C.NGW;
            if (row < MLAT) { const float rstd = 1.0f / sqrtf(ss[q] * (1.0f / 1024.0f) + 1e-6f);
#pragma unroll
                for (int j = 0; j < 4; ++j) { const int c = 4 * LANE + 256 * j; *(f32x4*)(out + (size_t)row * 1024 + c) = v[q][j] * rstd * *(const f32x4*)(nw + c); } } }
    }
}

__device__ __forceinline__ float dpp_red8(float v) {
    int x = __builtin_bit_cast(int, v);
    v += __builtin_bit_cast(float, __builtin_amdgcn_update_dpp(0, x, 0xB1, 0xF, 0xF, false)); x = __builtin_bit_cast(int, v);
    v += __builtin_bit_cast(float, __builtin_amdgcn_update_dpp(0, x, 0x4E, 0xF, 0xF, false)); x = __builtin_bit_cast(int, v);
    v += __builtin_bit_cast(float, __builtin_amdgcn_update_dpp(0, x, 0x141, 0xF, 0xF, false));
    return v;
}
__device__ __forceinline__ int scan_row(int z, int b, int s) {
    if (s < CTX_) return MLAT + b * CTX_ + (z ? CTX_ - 1 - s : s);
    const int sp = s - CTX_; return b * T_ + (z ? T_ - 1 - sp : sp);
}
__device__ __forceinline__ void scan_phase(KArgs a, const Ctx& C) {
    TID_INIT
    if (C.bx >= 128) return;
    const int z = C.bx >> 6, b = (C.bx >> 4) & 3, hd = C.bx & 15;
    const int tid = TID, lane = LANE, wave = C.wave;
    LAS float* Wd = (LAS float*)C.lds; LAS float* Kd = Wd + 2048; LAS float* Bb = Kd + 2048; LAS float* Aa = Bb + 2048; LAS float* Rr = Aa + 2048; LAS float* Vv = Rr + 2048;
    LAS float* Raw = Vv + 2048;
    LAS float* Yb = Raw + 4096;
    const bf16* rp = (const bf16*)(C.ws + WS_RKV); const bf16* kp = rp + PLANE; const bf16* vp = kp + PLANE; const bf16* L1 = (const bf16*)(C.ws + WS_L1);
    bf16* yout = (bf16*)(C.ws + (z ? WS_Y1 : WS_Y0)); float* bon = (float*)(C.ws + WS_BON) + (size_t)z * MTOK * 16;
    const int mat = (wave >> 1) & 1, nh = wave & 1, hi = lane >> 5, r32 = lane & 31;
    bf16x8 bfrag[4];
    {
        const float* W2 = (mat ? a->in[20] : a->in[17]) + (size_t)z * 64 * 1024 + hd * 64 + 32 * nh + r32;
#pragma unroll
        for (int ks = 0; ks < 4; ++ks) { float t[8];
#pragma unroll
            for (int i = 0; i < 8; ++i) t[i] = W2[(size_t)(16 * ks + 8 * hi + i) * 1024];
            const v4u w = (v4u){pk2(t[0], t[1]), pk2(t[2], t[3]), pk2(t[4], t[5]), pk2(t[6], t[7])}; bfrag[ks] = __builtin_bit_cast(bf16x8, w); }
    }
    const int te = tid >> 4, j4 = (tid & 15) * 4, ch = hd * 64 + j4;
    const f32x4 kk_c = *(const f32x4*)(a->in[23] + ch), ka_c = *(const f32x4*)(a->in[24] + ch), rk_c = *(const f32x4*)(a->in[25] + ch);
    const f32x4 w0_c = *(const f32x4*)(a->in[15] + z * 1024 + ch), a0_c = *(const f32x4*)(a->in[18] + z * 1024 + ch);
    const int ri = 8 * wave + (lane >> 3), j0 = 8 * (lane & 7);
    float S[8];
#pragma unroll
    for (int j = 0; j < 8; ++j) S[j] = 0.f;
    for (int c = 0; c < KVR / 32; ++c) {
        const int s0 = 32 * c;
        if (wave < 4) {
            const int row = scan_row(z, b, s0 + r32);
            const bf16* lp = L1 + (size_t)row * 768 + mat * 256 + 64 * z + 8 * hi;
            f32x16 acc = {};
#pragma unroll
            for (int ks = 0; ks < 4; ++ks) { const bf16x8 af = *(const bf16x8*)(lp + 16 * ks); acc = __builtin_amdgcn_mfma_f32_32x32x16_bf16(af, bfrag[ks], acc, 0, 0, 0); }
#pragma unroll
            for (int r = 0; r < 16; ++r) { const int t = (r & 3) + 8 * (r >> 2) + 4 * hi; Raw[mat * 2048 + t * 64 + 32 * nh + r32] = acc[r]; }
        }
        __syncthreads();
        {
            const int row = scan_row(z, b, s0 + te); const size_t o = (size_t)row * 1024 + ch;
            const v2u kb = *(const v2u*)(kp + o), rb = *(const v2u*)(rp + o), vb = *(const v2u*)(vp + o);
            const f32x4 k = (f32x4){bflo(kb.x), bfhi(kb.x), bflo(kb.y), bfhi(kb.y)}, r = (f32x4){bflo(rb.x), bfhi(rb.x), bflo(rb.y), bfhi(rb.y)}, v = (f32x4){bflo(vb.x), bfhi(vb.x), bflo(vb.y), bfhi(vb.y)};
            const f32x4 wr = *(const LAS f32x4*)(Raw + te * 64 + j4) + w0_c, ar = *(const LAS f32x4*)(Raw + 2048 + te * 64 + j4) + a0_c;
            f32x4 dec, aa;
#pragma unroll
            for (int j = 0; j < 4; ++j) { dec[j] = __expf(-0.6065306597126334f * sigm(wr[j])); aa[j] = sigm(ar[j]); }
            const f32x4 kkr = k * kk_c; float n2 = (kkr.x * kkr.x + kkr.y * kkr.y) + (kkr.z * kkr.z + kkr.w * kkr.w);
            n2 += __shfl_xor(n2, 1); n2 += __shfl_xor(n2, 2); n2 += __shfl_xor(n2, 4); n2 += __shfl_xor(n2, 8);
            const float inv = 1.0f / fmaxf(sqrtf(n2), 1e-12f);
            const f32x4 kk = kkr * inv, kdir = k * ((aa - 1.0f) * ka_c + 1.0f), bv = kk * aa;
            const f32x4 pb = r * kdir * rk_c; float sb = (pb.x + pb.y) + (pb.z + pb.w);
            sb += __shfl_xor(sb, 1); sb += __shfl_xor(sb, 2); sb += __shfl_xor(sb, 4); sb += __shfl_xor(sb, 8);
            if ((tid & 15) == 0) bon[(size_t)row * 16 + hd] = sb;
            const int lo = te * 64 + j4;
            *(LAS f32x4*)(Wd + lo) = dec; *(LAS f32x4*)(Kd + lo) = kdir; *(LAS f32x4*)(Bb + lo) = bv; *(LAS f32x4*)(Aa + lo) = -kk; *(LAS f32x4*)(Rr + lo) = r; *(LAS f32x4*)(Vv + lo) = v;
        }
        __syncthreads();
#pragma unroll 2
        for (int sl = 0; sl < 32; ++sl) {
            const int lo = sl * 64 + j0;
            const f32x4 w0 = *(const LAS f32x4*)(Wd + lo), w1 = *(const LAS f32x4*)(Wd + lo + 4), k0 = *(const LAS f32x4*)(Kd + lo), k1 = *(const LAS f32x4*)(Kd + lo + 4);
            const f32x4 b0 = *(const LAS f32x4*)(Bb + lo), b1 = *(const LAS f32x4*)(Bb + lo + 4), a0 = *(const LAS f32x4*)(Aa + lo), a1 = *(const LAS f32x4*)(Aa + lo + 4);
            const f32x4 r0 = *(const LAS f32x4*)(Rr + lo), r1 = *(const LAS f32x4*)(Rr + lo + 4); const float vi = Vv[sl * 64 + ri];
            float sa = ((S[0] * a0.x + S[1] * a0.y) + (S[2] * a0.z + S[3] * a0.w)) + ((S[4] * a1.x + S[5] * a1.y) + (S[6] * a1.z + S[7] * a1.w));
            sa = dpp_red8(sa);
            S[0] = S[0] * w0.x + (sa * b0.x + vi * k0.x); S[1] = S[1] * w0.y + (sa * b0.y + vi * k0.y); S[2] = S[2] * w0.z + (sa * b0.z + vi * k0.z); S[3] = S[3] * w0.w + (sa * b0.w + vi * k0.w);
            S[4] = S[4] * w1.x + (sa * b1.x + vi * k1.x); S[5] = S[5] * w1.y + (sa * b1.y + vi * k1.y); S[6] = S[6] * w1.z + (sa * b1.z + vi * k1.z); S[7] = S[7] * w1.w + (sa * b1.w + vi * k1.w);
            float y = ((S[0] * r0.x + S[1] * r0.y) + (S[2] * r0.z + S[3] * r0.w)) + ((S[4] * r1.x + S[5] * r1.y) + (S[6] * r1.z + S[7] * r1.w));
            y = dpp_red8(y);
            if ((lane & 7) == 0) Yb[sl * 64 + ri] = y;
        }
        __syncthreads();
        {
            const int row = scan_row(z, b, s0 + te); const f32x4 y = *(const LAS f32x4*)(Yb + te * 64 + j4);
            *(v2u*)(yout + (size_t)row * 1024 + ch) = (v2u){pk2(y.x, y.y), pk2(y.z, y.w)};
        }
    }
}


constexpr size_t WS_INVN = 5632 * 1024;
__device__ __forceinline__ void knorm_phase(KArgs a, const Ctx& C) {
    TID_INIT
    const bf16* kp = (const bf16*)(C.ws + WS_RKV) + PLANE; float* invn = (float*)(C.ws + WS_INVN);
    const int c0 = 16 * LANE; float kk[16];
#pragma unroll
    for (int i = 0; i < 16; ++i) kk[i] = a->in[23][c0 + i];
    for (int row = C.gw; row < MTOK; row += C.NGW) {
        const v4u p0 = *(const v4u*)(kp + (size_t)row * 1024 + c0), p1 = *(const v4u*)(kp + (size_t)row * 1024 + c0 + 8); float s = 0.f;
#pragma unroll
        for (int q = 0; q < 4; ++q) { const float x0 = bflo(p0[q]) * kk[2 * q], x1 = bfhi(p0[q]) * kk[2 * q + 1], x2 = bflo(p1[q]) * kk[8 + 2 * q], x3 = bfhi(p1[q]) * kk[9 + 2 * q]; s += (x0 * x0 + x1 * x1) + (x2 * x2 + x3 * x3); }
        s += __shfl_xor(s, 1); s += __shfl_xor(s, 2);
        if ((LANE & 3) == 0) invn[(size_t)row * 16 + (LANE >> 2)] = 1.0f / fmaxf(sqrtf(s), 1e-12f);
    }
}
constexpr int SC_RAW = 0, SC_BCB = 32768, SC_BCSZ = 18432, SC_AR = 0, SC_BK = 4608, SC_BKH = 9216, SC_VT = 14336, SC_GC = 17408, SC_BONP = 17664;
constexpr int SC_MB = SC_BCB + 3 * SC_BCSZ, SC_MSZ = 4096, SC_MAB = 0, SC_MK = 1024, SC_MBB = 2560, SC_W2F = SC_MB + 2 * SC_MSZ;
static_assert(SC_W2F + 16384 <= RING_BYTES, "scan LDS map");
__device__ __forceinline__ float dpp_red16(float v) {
    int x = __builtin_bit_cast(int, v);
    v += __builtin_bit_cast(float, __builtin_amdgcn_update_dpp(0, x, 0xB1, 0xF, 0xF, false)); x = __builtin_bit_cast(int, v);
    v += __builtin_bit_cast(float, __builtin_amdgcn_update_dpp(0, x, 0x4E, 0xF, 0xF, false)); x = __builtin_bit_cast(int, v);
    v += __builtin_bit_cast(float, __builtin_amdgcn_update_dpp(0, x, 0x141, 0xF, 0xF, false)); x = __builtin_bit_cast(int, v);
    v += __builtin_bit_cast(float, __builtin_amdgcn_update_dpp(0, x, 0x140, 0xF, 0xF, false));
    return v;
}
#define SC_BAR() asm volatile("s_waitcnt lgkmcnt(0)\n\ts_barrier" ::: "memory")
__device__ __forceinline__ void scan2_phase(KArgs a, const Ctx& C) {
    TID_INIT
    if (C.bx >= 128) return;
    const int z = C.bx >> 6, b = (C.bx >> 4) & 3, hd = C.bx & 15;
    const int lane = LANE, wave = C.wave, hi = lane >> 5, r32 = lane & 31;
    LAS unsigned char* L = C.lds;
    const bf16* rp = (const bf16*)(C.ws + WS_RKV); const bf16* kp = rp + PLANE; const bf16* vp = kp + PLANE; const bf16* L1 = (const bf16*)(C.ws + WS_L1);
    const float* invn = (const float*)(C.ws + WS_INVN);
    bf16* yout = (bf16*)(C.ws + (z ? WS_Y1 : WS_Y0)); float* bon = (float*)(C.ws + WS_BON) + (size_t)z * MTOK * 16;
    constexpr int NCH = KVR / 16;
    for (int f = wave; f < 16; f += 8) { const int mat = f >> 3, nh = (f >> 2) & 1, ks = f & 3;
        const float* W2 = (mat ? a->in[20] : a->in[17]) + (size_t)z * 64 * 1024 + hd * 64 + 32 * nh + r32; float t[8];
#pragma unroll
        for (int i = 0; i < 8; ++i) t[i] = W2[(size_t)(16 * ks + 8 * hi + i) * 1024];
        *(LAS v4u*)(L + SC_W2F + f * 1024 + lane * 16) = (v4u){pk2(t[0], t[1]), pk2(t[2], t[3]), pk2(t[4], t[5]), pk2(t[6], t[7])}; }
    for (int i = TID; i < 2 * 16 * 12; i += 512) { const int bb = i / 192, rem = i % 192; *(LAS unsigned*)(L + SC_MB + bb * SC_MSZ + SC_MBB + (rem / 12) * 48 + (rem % 12) * 4) = 0u; }
    f32x16 S0 = {}, S1 = {};
    const int role = wave < 2 ? 0 : (wave == 4 ? 1 : (wave == 5 ? 2 : 3));
    const int jj = lane & 15, tq = lane >> 4, wq = (wave & 1) | ((wave >> 2) << 1), jch = 16 * wq + jj, ch = hd * 64 + jch;
    const float kkc = a->in[23][ch], kac = a->in[24][ch], rkc = a->in[25][ch], w0c = a->in[15][z * 1024 + ch], a0c = a->in[18][z * 1024 + ch];
    const int pj2 = 2 * ((jch & ~12) | ((jch & 4) << 1) | ((jch & 8) >> 1));
    v4u lf[4];
#define PK_(e) lf[e].x
#define PR_(e) lf[e].y
#define PV_(e) lf[e].z
#define PIN_(e) lf[e].w
    const int p0_ = z ? 15 - 4 * tq : 4 * tq, pst_ = z ? -1 : 1;
#define SC_PREFETCH(qq) do { const int rmin_ = z ? scan_row(z, b, 16 * (qq) + 15) : scan_row(z, b, 16 * (qq)); const bf16* kb_ = kp + (size_t)rmin_ * 1024; const bf16* rb2_ = rp + (size_t)rmin_ * 1024; const bf16* vb_ = vp + (size_t)rmin_ * 1024; const float* ib2_ = invn + (size_t)rmin_ * 16 + hd; \
        _Pragma("unroll") for (int e = 0; e < 4; ++e) { const unsigned pe_ = (unsigned)(p0_ + pst_ * e), o_ = pe_ * 1024u + (unsigned)ch; PK_(e) = kb_[o_]; PR_(e) = rb2_[o_]; PV_(e) = vb_[o_]; PIN_(e) = __float_as_uint(ib2_[pe_ * 16u]); } } while (0)
    SC_BAR();
    if (role == 3) {
        SC_PREFETCH(0);
    } else if (role == 2) {
        const int row = scan_row(z, b, r32);
#pragma unroll
        for (int ks = 0; ks < 4; ++ks) lf[ks] = *(const v4u*)(L1 + (size_t)row * 768 + 64 * z + 16 * ks + 8 * hi);
    }
#pragma unroll 1
    for (int n = -4; n < NCH; ++n) {
        if (role == 0) {
            if (n >= 0) {
                LAS unsigned char* B = L + SC_BCB + (n % 3) * SC_BCSZ; LAS unsigned char* Mb = L + SC_MB + (n & 1) * SC_MSZ;
                bf16x8 Sb[4];
#pragma unroll
                for (int ks = 0; ks < 4; ++ks) { v4u w;
#pragma unroll
                    for (int e2 = 0; e2 < 4; ++e2) { const int r = 8 * (ks & 1) + 2 * e2; w[e2] = (ks < 2) ? pk2(S0[r], S0[r + 1]) : pk2(S1[r], S1[r + 1]); }
                    Sb[ks] = __builtin_bit_cast(bf16x8, w); }
                f32x16 acc = {};
#pragma unroll
                for (int ks = 0; ks < 4; ++ks) { const bf16x8 af = *(const LAS bf16x8*)(B + SC_AR + r32 * 144 + 32 * ks + 16 * hi); acc = __builtin_amdgcn_mfma_f32_32x32x16_bf16(af, Sb[ks], acc, 0, 0, 0); }
                const bf16x8 Vf = *(const LAS bf16x8*)(B + SC_VT + (32 * wave + r32) * 48 + 16 * hi);
                { const bf16x8 mk = *(const LAS bf16x8*)(Mb + SC_MK + r32 * 48 + 16 * hi); acc = __builtin_amdgcn_mfma_f32_32x32x16_bf16(mk, Vf, acc, 0, 0, 0); }
                float X[16];
#pragma unroll
                for (int r = 0; r < 8; ++r) { float xa = acc[r], xb = acc[r];
                    asm volatile("s_nop 1\n\tv_permlane32_swap_b32 %0, %1" : "+v"(xa), "+v"(xb));
                    const int t0 = (r & 3) + 8 * (r >> 2); X[t0] = xa; X[t0 + 4] = xb; }
                float ev[16];
#pragma unroll
                for (int qb = 0; qb < 4; ++qb) {
                    const f32x4 m1 = *(const LAS f32x4*)(Mb + SC_MAB + (4 * qb + 1) * 64 + qb * 16), m2 = *(const LAS f32x4*)(Mb + SC_MAB + (4 * qb + 2) * 64 + qb * 16), m3 = *(const LAS f32x4*)(Mb + SC_MAB + (4 * qb + 3) * 64 + qb * 16);
                    const float e0 = X[4 * qb]; const float e1 = X[4 * qb + 1] + m1.x * e0; const float e2 = X[4 * qb + 2] + (m2.x * e0 + m2.y * e1); const float e3 = X[4 * qb + 3] + ((m3.x * e0 + m3.y * e1) + m3.z * e2);
                    ev[4 * qb] = e0; ev[4 * qb + 1] = e1; ev[4 * qb + 2] = e2; ev[4 * qb + 3] = e3;
#pragma unroll
                    for (int t = 4 * qb + 4; t < 16; ++t) { const f32x4 mt = *(const LAS f32x4*)(Mb + SC_MAB + t * 64 + qb * 16); X[t] += (mt.x * e0 + mt.y * e1) + (mt.z * e2 + mt.w * e3); }
                    __builtin_amdgcn_sched_barrier(0); }
                v4u ew;
#pragma unroll
                for (int e2 = 0; e2 < 4; ++e2) { float x0 = ev[2 * e2], x1 = ev[2 * e2 + 1], x2 = ev[8 + 2 * e2], x3 = ev[9 + 2 * e2]; asm volatile("" : "+v"(x0), "+v"(x1), "+v"(x2), "+v"(x3));
                    ew[e2] = pk2(hi ? x2 : x0, hi ? x3 : x1); }
                const bf16x8 Eb = __builtin_bit_cast(bf16x8, ew);
                { const bf16x8 mb = *(const LAS bf16x8*)(Mb + SC_MBB + r32 * 48 + 16 * hi); acc = __builtin_amdgcn_mfma_f32_32x32x16_bf16(mb, Eb, acc, 0, 0, 0); }
#pragma unroll
                for (int r = 8; r < 16; ++r) { const int t = (r & 3) + 8 * ((r - 8) >> 2) + 4 * hi; const unsigned yo = (unsigned)(z ? 15 - t : t) * 1024u + (unsigned)r32;
                    const int rmin = z ? scan_row(z, b, 16 * n + 15) : scan_row(z, b, 16 * n); (yout + (size_t)rmin * 1024 + hd * 64 + 32 * wave)[yo] = (bf16)f2bf(acc[r]); }
#pragma unroll
                for (int q = 0; q < 4; ++q) { const f32x4 g0 = *(const LAS f32x4*)(B + SC_GC + (8 * q + 4 * hi) * 4), g1 = *(const LAS f32x4*)(B + SC_GC + (32 + 8 * q + 4 * hi) * 4);
#pragma unroll
                    for (int e = 0; e < 4; ++e) { S0[4 * q + e] *= g0[e]; S1[4 * q + e] *= g1[e]; } }
                { const bf16x8 a00 = *(const LAS bf16x8*)(B + SC_BKH + r32 * 80 + 16 * hi), a01 = *(const LAS bf16x8*)(B + SC_BKH + r32 * 80 + 32 + 16 * hi);
                  const bf16x8 a10 = *(const LAS bf16x8*)(B + SC_BKH + (32 + r32) * 80 + 16 * hi), a11 = *(const LAS bf16x8*)(B + SC_BKH + (32 + r32) * 80 + 32 + 16 * hi);
                  S0 = __builtin_amdgcn_mfma_f32_32x32x16_bf16(a00, Eb, S0, 0, 0, 0); S0 = __builtin_amdgcn_mfma_f32_32x32x16_bf16(a01, Vf, S0, 0, 0, 0);
                  S1 = __builtin_amdgcn_mfma_f32_32x32x16_bf16(a10, Eb, S1, 0, 0, 0); S1 = __builtin_amdgcn_mfma_f32_32x32x16_bf16(a11, Vf, S1, 0, 0, 0); }
            }
        } else if (role == 1) {
            const int mc = n + 1;
            if (mc >= 0 && mc < NCH) {
                LAS unsigned char* B = L + SC_BCB + (mc % 3) * SC_BCSZ; LAS unsigned char* Mb = L + SC_MB + (mc & 1) * SC_MSZ;
                f32x16 acc = {};
#pragma unroll
                for (int ks = 0; ks < 4; ++ks) { const bf16x8 af = *(const LAS bf16x8*)(B + SC_AR + r32 * 144 + 32 * ks + 16 * hi), bfr = *(const LAS bf16x8*)(B + SC_BK + r32 * 144 + 32 * ks + 16 * hi);
                    acc = __builtin_amdgcn_mfma_f32_32x32x16_bf16(af, bfr, acc, 0, 0, 0); }
#pragma unroll
                for (int r = 0; r < 16; ++r) { const int tp = (r & 3) + 8 * (r >> 2) + 4 * hi; const float v = acc[r];
                    if (r32 < 16) { if (tp < 16) *(LAS float*)(Mb + SC_MAB + tp * 64 + r32 * 4) = (r32 < tp) ? v : 0.f;
                                    else *(LAS bf16*)(Mb + SC_MBB + tp * 48 + r32 * 2) = (bf16)f2bf((r32 <= tp - 16) ? v : 0.f); }
                    else { const int tau = r32 - 16; const bool keep = tp < 16 ? (tau < tp) : (tau <= tp - 16); *(LAS bf16*)(Mb + SC_MK + tp * 48 + tau * 2) = (bf16)f2bf(keep ? v : 0.f); } }
                if (lane < 16) { const f32x4 p = *(const LAS f32x4*)(B + SC_BONP + lane * 16); bon[(size_t)scan_row(z, b, 16 * mc + lane) * 16 + hd] = (p.x + p.y) + (p.z + p.w); }
            }
        } else if (role == 2) {
            const int mat = (n + 4) & 1, p = (n + 4 - mat) >> 1;
            if (32 * p < KVR) {
                f32x16 a0 = {}, a1 = {};
#pragma unroll
                for (int ks = 0; ks < 4; ++ks) asm volatile("" : "+v"(lf[ks]));
#pragma unroll
                for (int ks = 0; ks < 4; ++ks) { const bf16x8 af = __builtin_bit_cast(bf16x8, lf[ks]);
                    const bf16x8 b0 = *(const LAS bf16x8*)(L + SC_W2F + ((mat * 2 + 0) * 4 + ks) * 1024 + lane * 16), b1 = *(const LAS bf16x8*)(L + SC_W2F + ((mat * 2 + 1) * 4 + ks) * 1024 + lane * 16);
                    a0 = __builtin_amdgcn_mfma_f32_32x32x16_bf16(af, b0, a0, 0, 0, 0); a1 = __builtin_amdgcn_mfma_f32_32x32x16_bf16(af, b1, a1, 0, 0, 0); }
                LAS float* Raw = (LAS float*)(L + SC_RAW + (p & 1) * 16384 + mat * 8192);
#pragma unroll
                for (int r = 0; r < 16; ++r) { const int t = (r & 3) + 8 * (r >> 2) + 4 * hi; Raw[t * 64 + r32] = a0[r]; Raw[t * 64 + 32 + r32] = a1[r]; }
            }
            { const int n2 = n + 1, mat2 = (n2 + 4) & 1, p2 = (n2 + 4 - mat2) >> 1;
              if (32 * p2 < KVR) { const int row = scan_row(z, b, 32 * p2 + r32);
#pragma unroll
                  for (int ks = 0; ks < 4; ++ks) lf[ks] = *(const v4u*)(L1 + (size_t)row * 768 + mat2 * 256 + 64 * z + 16 * ks + 8 * hi); } }
        } else {
            const int q = n + 2;
            if (q >= 0 && q < NCH) {
                LAS unsigned char* B = L + SC_BCB + (q % 3) * SC_BCSZ;
                const LAS float* Raw = (const LAS float*)(L + SC_RAW + ((q >> 1) & 1) * 16384) + (16 * (q & 1) + 4 * tq) * 64 + jch;
                float ewv[4], av[4], bv[4], kd[4], rv[4], bs[4];
#pragma unroll
                for (int e = 0; e < 4; ++e) asm volatile("" : "+v"(lf[e]));
#pragma unroll
                for (int e = 0; e < 4; ++e) { const unsigned kb_ = PK_(e), rb_ = PR_(e), ib_ = PIN_(e); const float kv = bflo(kb_), pin_e = __uint_as_float(ib_); rv[e] = bflo(rb_);
                    const float wr = Raw[e * 64] + w0c, ar = Raw[2048 + e * 64] + a0c;
                    ewv[e] = 0.6065306597126334f * sigf(wr); const float aa = sigf(ar), kk = kv * kkc * pin_e;
                    av[e] = -kk; bv[e] = kk * aa; kd[e] = kv * ((aa - 1.0f) * kac + 1.0f); bs[e] = rv[e] * kd[e] * rkc; }
                const unsigned v0_ = PV_(0), v1_ = PV_(1), v2_ = PV_(2), v3_ = PV_(3); v2u vt; vt.x = v0_ | (v1_ << 16); vt.y = v2_ | (v3_ << 16);
                *(LAS v2u*)(B + SC_VT + jch * 48 + 8 * tq) = vt;
                if (q + 1 < NCH) SC_PREFETCH(q + 1);
                const float loc = (ewv[0] + ewv[1]) + (ewv[2] + ewv[3]);
                float pa_ = loc, pb_ = loc;
                asm volatile("s_nop 1\n\tv_permlane16_swap_b32 %0, %1" : "+v"(pa_), "+v"(pb_));
                const float pair_ = pa_ + pb_; float pc_ = pair_, pd_ = pair_;
                asm volatile("s_nop 1\n\tv_permlane32_swap_b32 %0, %1" : "+v"(pc_), "+v"(pd_));
                const float excl = ((tq & 1) ? pa_ : 0.f) + ((tq & 2) ? pc_ : 0.f);
                const float LC = pc_ + pd_, gC = __expf(-LC);
                float Lp = excl; float gprev = __expf(-Lp);
                float bh[4], kh[4];
#pragma unroll
                for (int e = 0; e < 4; ++e) { const float Le = Lp + ewv[e], g = __expf(-Le), ig = __builtin_amdgcn_rcpf(g); const int t = 4 * tq + e;
                    const unsigned par = pk2(gprev * av[e], g * rv[e]);
                    *(LAS bf16*)(B + SC_AR + t * 144 + pj2) = (bf16)(par & 0xffffu); *(LAS bf16*)(B + SC_AR + (16 + t) * 144 + pj2) = (bf16)(par >> 16);
                    const float bt = bv[e] * ig, kt = kd[e] * ig; const unsigned pbk = pk2(bt, kt);
                    *(LAS bf16*)(B + SC_BK + t * 144 + pj2) = (bf16)(pbk & 0xffffu); *(LAS bf16*)(B + SC_BK + (16 + t) * 144 + pj2) = (bf16)(pbk >> 16);
                    bh[e] = bt * gC; kh[e] = kt * gC; Lp = Le; gprev = g; }
                *(LAS v2u*)(B + SC_BKH + jch * 80 + 8 * tq) = (v2u){pk2(bh[0], bh[1]), pk2(bh[2], bh[3])};
                *(LAS v2u*)(B + SC_BKH + jch * 80 + 32 + 8 * tq) = (v2u){pk2(kh[0], kh[1]), pk2(kh[2], kh[3])};
                if (tq == 3) *(LAS float*)(B + SC_GC + jch * 4) = gC;
#pragma unroll
                for (int e = 0; e < 4; ++e) { const float s = dpp_red16(bs[e]); if (jj == 0) *(LAS float*)(B + SC_BONP + (4 * tq + e) * 16 + wq * 4) = s; }
            }
        }
        SC_BAR();
    }
}

__device__ __forceinline__ void attention_phase(const Ctx& C, char* lds_generic) {
    using abf = attn2::bf16;
    const abf* Q = (const abf*)(C.ws + WS_Q); const abf* K = (const abf*)(C.ws + WS_K); const abf* V = (const abf*)(C.ws + WS_V); abf* O1 = (abf*)(C.ws + WS_O1);
    const int vcu = (C.G % 8 == 0) ? (C.bx % 8) * (C.G / 8) + C.bx / 8 : C.bx;
#pragma unroll 1
    for (int it = vcu; it < 2048 + 64; it += C.G) {
        const abf *Qb, *Kh, *Vh; abf* Ob; int seq;
        if (it < 2048) {
            int id = it; if (2048 % C.G == 0) id = (it % C.G) * (2048 / C.G) + it / C.G;
            int bs = id >> 5, qb = id & 31;
            if (C.G == 256) { const int v_ = it & 255, r_ = it >> 8; bs = 8 * (v_ >> 5) + r_; qb = v_ & 31; }
            const int b = bs >> 4, s = bs & 15;
            Qb = Q + ((size_t)b * T_ + (size_t)qb * 256) * 1024 + s * 64; Kh = K + (size_t)b * KVR * 1024 + s * 64; Vh = V + (size_t)b * KVR * 1024 + (s >> 1) * 128;
            Ob = O1 + ((size_t)b * T_ + (size_t)qb * 256) * 2048 + s * 128; seq = KVR;
        } else {
            const int id = it - 2048, b = id >> 4, s = id & 15;
            Qb = Q + ((size_t)MLAT + (size_t)b * CTX_) * 1024 + s * 64; Kh = K + ((size_t)b * KVR + T_) * 1024 + s * 64; Vh = V + ((size_t)b * KVR + T_) * 1024 + (s >> 1) * 128;
            Ob = O1 + ((size_t)MLAT + (size_t)b * CTX_) * 2048 + s * 128; seq = CTX_;
        }
        attn2::attn_dense_body(Qb, Kh, Vh, Ob, seq, lds_generic);
    }
}

template <class Epi> __device__ __forceinline__ void run_gemm(const Ctx& C, const bf16* A, int lda, const bf16* Bt, int M, int N, int K, const Epi& E) {
    pg8::Gemm g{A, Bt, M, N, K, lda, K}; pg8::StaticOrder S; S.init(M, N, C.G, C.bx);
#ifndef NO_GEMM
    pg8::gemm_phase<Epi, pg8::StaticOrder, true, true>(C.lds, g, S, E);
#endif
}

__device__ __forceinline__ Ctx make_ctx(KArgs ka, LAS unsigned char* lds) {
    Ctx C; C.wave = __builtin_amdgcn_readfirstlane(tid_opaque() >> 6); C.G = sgpr_opaque(gridDim.x); C.bx = sgpr_opaque(blockIdx.x); C.gw = C.bx * 8 + C.wave; C.NGW = C.G * 8; C.lds = lds;
    C.ws = ka->ws; C.hlat = (bf16*)ka->out; C.hctx = (float*)(C.ws + WS_HCTX); C.mod = (const float*)(C.ws + WS_MOD); return C;
}
__device__ __forceinline__ void run_gemm_ctx(const Ctx& C, const bf16* A, int lda, const bf16* Bt, int K, float* dst_ctx, const float* gate, float gs) {
    pg8::Gemm g{A, Bt, MTOK, 1024, K / 2, lda, K}; pg8::CtxSplitOrder S{C.bx, K};
    pg8::gemm_phase<pg8::EpiResAtomic, pg8::CtxSplitOrder, true, true>(C.lds, g, S, pg8::EpiResAtomic{dst_ctx, gate, gs});
}
__global__ void __launch_bounds__(512, 2) mega_fwd(Args args_unused) {
    extern __shared__ __attribute__((aligned(16))) unsigned char lds[];
    cg::grid_group grid = cg::this_grid();
    int ph = 0;
    tid_table_init();
    { if (threadIdx.x < 2) ((LAS unsigned*)((LAS unsigned char*)lds + LDS_XB))[threadIdx.x] = 0u; __syncthreads();
      const KArgs k0 = kargs(); (void)xcd_barrier_post((unsigned*)(k0->ws + WS_XBAR), (volatile LAS unsigned*)((LAS unsigned char*)lds + LDS_XB)); }
#define PHASE_BEGIN { const KArgs ka = kargs(); if (ka->ph_lo <= ph && ph < ka->ph_hi) { const Ctx C = make_ctx(ka, (LAS unsigned char*)lds); unsigned char* const ws = C.ws; \
        const float* const modl = C.mod + (size_t)l * 5 * 9216; const float* const nw = ka->in[6] + (size_t)l * 3 * 1024; (void)ws; (void)modl; (void)nw;
#define PHASE_END } } { const KArgs kb = kargs(); if (kb->ph_lo <= ph && ph + 1 < kb->ph_hi) { if (ph == 0) grid.sync(); else { XcdBarrier xb_; xb_.bar = (unsigned*)(kb->ws + WS_XBAR); xb_.x = xb_xcc_id(); xb_.st = (volatile LAS unsigned*)((LAS unsigned char*)lds + LDS_XB); xcd_barrier(xb_); } } } ++ph;
#define WPTR(off) ((bf16*)(ws + (off)))
    { const int l = 0; PHASE_BEGIN adaln_phase(ka, C); __syncthreads(); convert_layer_weights(ka, C, 0);
        { const int t_ = tid_opaque(); const f32x4* s_ = (const f32x4*)ka->in[2]; f32x4* d_ = (f32x4*)C.hctx; for (int i = C.bx * 512 + t_; i < MCTX * 1024 / 4; i += C.G * 512) d_[i] = s_[i]; }
        PHASE_END }

#pragma unroll 1
    for (int l = 0; l < 2; ++l) {
        PHASE_BEGIN modnorm_phase(C, l == 0 ? ka->in[0] : nullptr, C.hlat, l == 0 ? ka->in[2] : C.hctx, MTOK, nw, modl, 0, WPTR(WS_U), 1024); if (l == 1) convert_layer_weights(ka, C, 1); PHASE_END
        PHASE_BEGIN run_gemm(C, WPTR(WS_U), 1024, WPTR(WS_W13A), MTOK, 2 * FF_, 1024, pg8::EpiSwiglu{WPTR(WS_ACT), FF_}); PHASE_END
        PHASE_BEGIN run_gemm(C, WPTR(WS_ACT), FF_, WPTR(WS_W2A), MLAT, 1024, FF_, pg8::EpiRes{l == 0 ? ka->in[0] : nullptr, C.hlat, C.hlat, modl + 2 * 1024, 0.5f});
            run_gemm_ctx(C, WPTR(WS_ACT), FF_, WPTR(WS_W2A), FF_, C.hctx, modl + 2 * 1024, 0.5f); PHASE_END
        if (l == 0) {
            PHASE_BEGIN modnorm_phase(C, nullptr, C.hlat, C.hctx, MTOK, nw + 1024, modl, 3, WPTR(WS_U), 1024); PHASE_END
            PHASE_BEGIN run_gemm(C, WPTR(WS_U), 1024, WPTR(WS_WMIX), MTOK, 3072, 1024, pg8::EpiQKV{WPTR(WS_Q), WPTR(WS_K), WPTR(WS_V), (const float*)(ws + WS_COS), (const float*)(ws + WS_SIN), 0.125f * 1.4426950408889634f}); PHASE_END
            PHASE_BEGIN
#ifndef NO_ATT
            attention_phase(C, (char*)lds);
#endif
            PHASE_END
            PHASE_BEGIN attn_combine_phase(ka, C, WPTR(WS_O1), WPTR(WS_U)); PHASE_END
            PHASE_BEGIN run_gemm(C, WPTR(WS_U), 1024, WPTR(WS_WO), MLAT, 1024, 1024, pg8::EpiRes{nullptr, C.hlat, C.hlat, modl + 5 * 1024, 1.0f});
            run_gemm_ctx(C, WPTR(WS_U), 1024, WPTR(WS_WO), 1024, C.hctx, modl + 5 * 1024, 1.0f); PHASE_END
        } else {
            PHASE_BEGIN modnorm_phase(C, nullptr, C.hlat, C.hctx, MTOK, nw + 1024, modl, 3, WPTR(WS_A2), 2048); PHASE_END
            PHASE_BEGIN shift_phase(C, WPTR(WS_A2)); PHASE_END
            PHASE_BEGIN run_gemm(C, WPTR(WS_A2), 2048, WPTR(WS_WMIX), MTOK, 3840, 2048, pg8::EpiPlain{WPTR(WS_RKV), 1024, 1, PLANE, WPTR(WS_L1)}); PHASE_END
            PHASE_BEGIN run_gemm(C, WPTR(WS_L1) + 512, 768, WPTR(WS_G2T), MTOK, 1024, 256, pg8::EpiPlain{WPTR(WS_GG), 1024, 0, 0, nullptr}); knorm_phase(ka, C); PHASE_END
            PHASE_BEGIN
#ifndef NO_SCAN
#ifdef DUP_SCAN
#pragma unroll 1
            for (int rep_ = 0; rep_ < 2; ++rep_) { scan2_phase(ka, C); __syncthreads(); }
#else
            scan2_phase(ka, C);
#endif
#endif
            PHASE_END
            PHASE_BEGIN rwkv_finish_phase(ka, C, MLAT); PHASE_END
            PHASE_BEGIN run_gemm(C, WPTR(WS_FO), 1024, WPTR(WS_WO), MLAT, 1024, 1024, pg8::EpiRes{nullptr, C.hlat, C.hlat, modl + 5 * 1024, 1.0f}); PHASE_END
        }
        PHASE_BEGIN modnorm_phase(C, nullptr, C.hlat, C.hctx, l == 1 ? MLAT : MTOK, nw + 2048, modl, 6, WPTR(WS_U), 1024); PHASE_END
        PHASE_BEGIN run_gemm(C, WPTR(WS_U), 1024, WPTR(WS_W13B), l == 1 ? MLAT : MTOK, 2 * FF_, 1024, pg8::EpiSwiglu{WPTR(WS_ACT), FF_}); PHASE_END
        PHASE_BEGIN run_gemm(C, WPTR(WS_ACT), FF_, WPTR(WS_W2B), MLAT, 1024, FF_, pg8::EpiRes{nullptr, C.hlat, l == 1 ? WPTR(WS_U) : C.hlat, modl + 8 * 1024, 0.5f});
            if (l == 0) run_gemm_ctx(C, WPTR(WS_ACT), FF_, WPTR(WS_W2B), FF_, C.hctx, modl + 8 * 1024, 0.5f); PHASE_END
    }
    { const int l = 0; PHASE_BEGIN final_norm_phase(ka, C); PHASE_END }
}

#ifndef MK_PER_PHASE
#define MK_PER_PHASE 0
#endif
constexpr int N_PHASES = 1 + 11 + 13 + 1;
extern "C" void kernel_launch(void* const* d_in, const int* in_sizes, int n_in, void* d_out, int out_size, void* d_ws, size_t ws_size, hipStream_t stream) {
    static int grid = 0;
    if (grid == 0) {
        if (n_in != 30 || out_size != MLAT * 1024 || ws_size < WS_END) { fprintf(stderr, "kernel_launch: unexpected shapes (n_in %d out %d ws %zu)\n", n_in, out_size, ws_size); grid = -1; return; }
        int dev = 0, cus = 0, per_cu = 0;
        hipGetDevice(&dev); hipDeviceGetAttribute(&cus, hipDeviceAttributeMultiprocessorCount, dev);
        hipFuncSetAttribute((const void*)mega_fwd, hipFuncAttributeMaxDynamicSharedMemorySize, LDS_BYTES);
        hipOccupancyMaxActiveBlocksPerMultiprocessor(&per_cu, (const void*)mega_fwd, 512, LDS_BYTES);
        (void)hipGetLastError();
        if (per_cu < 1) per_cu = 1;
        grid = cus;
        if (grid > 256) grid = 256;
    }
    if (grid < 0) return;
    if (hipMemsetAsync((char*)d_ws + WS_XBAR, 0, 16384, stream) != hipSuccess) { fprintf(stderr, "kernel_launch: memset of the barrier words failed\n"); return; }
    Args a{};
    for (int i = 0; i < 30; ++i) a.in[i] = (const float*)d_in[i];
    a.out = (float*)d_out; a.ws = (unsigned char*)d_ws;
#ifdef DUP_PH
    a.ph_lo = 0; a.ph_hi = DUP_PH + 1;
    { void* kargs0[] = {&a}; (void)hipLaunchCooperativeKernel((const void*)mega_fwd, dim3(grid), dim3(512), kargs0, LDS_BYTES, stream); }
    (void)hipMemsetAsync((char*)d_ws + WS_XBAR, 0, 16384, stream);
    a.ph_lo = DUP_PH; a.ph_hi = N_PHASES;
#else
    a.ph_lo = 0; a.ph_hi = N_PHASES;
#endif
    void* kargs[] = {&a};
    hipError_t e = hipLaunchCooperativeKernel((const void*)mega_fwd, dim3(grid), dim3(512), kargs, LDS_BYTES, stream);
    if (e != hipSuccess) fprintf(stderr, "cooperative launch failed: %s (grid %d)\n", hipGetErrorString(e), grid);
}
```
